# Optimizing an MI355X kernel written in HIP

```python
import math
import jax, jax.numpy as jnp
from jax import lax
import numpy as np

D_MODEL = 1024
BATCH = 32
SEQ = 2048
DEPTH = 1

HEAD_DIM = 64
FOX_HEADS = 8
SWA_Q_HEADS = 8
SWA_KV_HEADS = 2
SWA_GROUP = SWA_Q_HEADS // SWA_KV_HEADS
WINDOW = 128
Q_BLOCK = 128
ROPE_THETA = 10000.0
D_FF = -(-8 * D_MODEL // (3 * 256)) * 256
DEEPNORM_ALPHA = (2 * DEPTH) ** 0.25
DEEPNORM_BETA = (8 * DEPTH) ** -0.25
LN_EPS = 1e-5

FOX_W = FOX_HEADS * HEAD_DIM
SWA_QW = SWA_Q_HEADS * HEAD_DIM
SWA_KVW = SWA_KV_HEADS * HEAD_DIM
IN_COLS = 3 * FOX_W + FOX_HEADS + SWA_QW + 2 * SWA_KVW + 2 * D_MODEL

kernel_name = "fox_swa_sink_gated_hybrid_deepnorm"


def layer_norm(x, g, b):
    xf = x.astype(jnp.float32)
    mu = jnp.mean(xf, axis=-1, keepdims=True)
    var = jnp.mean(jnp.square(xf - mu), axis=-1, keepdims=True)
    y = (xf - mu) * lax.rsqrt(var + LN_EPS)
    return (y * g.astype(jnp.float32) + b.astype(jnp.float32)).astype(x.dtype)


def apply_rope(x, pos):
    half = x.shape[-1] // 2
    inv_freq = ROPE_THETA ** (-jnp.arange(0, half, dtype=jnp.float32) / half)
    ang = pos[:, None] * inv_freq[None, :]
    cos = jnp.cos(ang)[None, :, None, :]
    sin = jnp.sin(ang)[None, :, None, :]
    xf = x.astype(jnp.float32)
    x1, x2 = xf[..., :half], xf[..., half:]
    out = jnp.concatenate([x1 * cos - x2 * sin, x2 * cos + x1 * sin], axis=-1)
    return out.astype(x.dtype)


def forgetting_attention(q, k, v, log_f):
    B, S, H, dh = q.shape
    nb = S // Q_BLOCK
    scale = 1.0 / math.sqrt(dh)
    c = jnp.cumsum(log_f, axis=1)
    cT = jnp.transpose(c, (0, 2, 1))
    qb = jnp.transpose(q.reshape(B, nb, Q_BLOCK, H, dh), (1, 0, 2, 3, 4))
    cb = jnp.transpose(c.reshape(B, nb, Q_BLOCK, H), (1, 0, 3, 2))
    kpos = jnp.arange(S)

    def one_block(args):
        qi, ci, i = args
        s = jnp.einsum('bqhd,bkhd->bhqk', qi, k, preferred_element_type=jnp.float32) * scale
        bias = ci[..., :, None] - cT[:, :, None, :]
        qpos = i * Q_BLOCK + jnp.arange(Q_BLOCK)
        mask = kpos[None, :] <= qpos[:, None]
        logits = jnp.where(mask[None, None], s + bias, -jnp.inf)
        p = jax.nn.softmax(logits, axis=-1)
        return jnp.einsum('bhqk,bkhd->bqhd', p.astype(v.dtype), v)

    out = lax.map(one_block, (qb, cb, jnp.arange(nb)))
    return jnp.transpose(out, (1, 0, 2, 3, 4)).reshape(B, S, H, dh)


def sliding_window_sink_attention(q, k, v, sinks):
    B, S, Hq, dh = q.shape
    W = WINDOW
    nb = S // W
    scale = 1.0 / math.sqrt(dh)
    qb = q.reshape(B, nb, W, SWA_KV_HEADS, SWA_GROUP, dh)

    def banded(t):
        tb = t.reshape(B, nb, W, SWA_KV_HEADS, dh)
        prev = jnp.concatenate([jnp.zeros_like(tb[:, :1]), tb[:, :-1]], axis=1)
        return jnp.concatenate([prev, tb], axis=2)

    kk, vv = banded(k), banded(v)
    s = jnp.einsum('bnqhgd,bnkhd->bnhgqk', qb, kk, preferred_element_type=jnp.float32) * scale
    i = jnp.arange(W)[:, None]
    j = jnp.arange(2 * W)[None, :]
    diff = W + i - j
    key_abs = jnp.arange(nb)[:, None, None] * W + j[None] - W
    mask = (diff >= 0)[None] & (diff < WINDOW)[None] & (key_abs >= 0)
    s = jnp.where(mask[None, :, None, None], s, -jnp.inf)
    sink = sinks.astype(jnp.float32).reshape(SWA_KV_HEADS, SWA_GROUP)[None, None, :, :, None, None]
    m = jnp.maximum(jnp.max(s, axis=-1, keepdims=True), sink)
    e = jnp.exp(s - m)
    denom = jnp.sum(e, axis=-1, keepdims=True) + jnp.exp(sink - m)
    p = e / denom
    out = jnp.einsum('bnhgqk,bnkhd->bnqhgd', p.astype(v.dtype), vv)
    return out.reshape(B, S, Hq, dh)


def hybrid_mixer(x, w_in, b_forget, attn_sinks, w_o_fox, w_o_swa, w_out):
    B, S, _ = x.shape
    proj = jnp.einsum('bsd,dc->bsc', x, w_in)
    sizes = [FOX_W, FOX_W, FOX_W, FOX_HEADS, SWA_QW, SWA_KVW, SWA_KVW, D_MODEL, D_MODEL]
    idx = list(np.cumsum(sizes)[:-1])
    q_f, k_f, v_f, f_logit, q_s, k_s, v_s, g_f, g_s = jnp.split(proj, idx, axis=-1)
    log_f = jax.nn.log_sigmoid((f_logit + b_forget).astype(jnp.float32))
    o_f = forgetting_attention(q_f.reshape(B, S, FOX_HEADS, HEAD_DIM),
                               k_f.reshape(B, S, FOX_HEADS, HEAD_DIM),
                               v_f.reshape(B, S, FOX_HEADS, HEAD_DIM), log_f)
    o_f = jnp.einsum('bsc,cd->bsd', o_f.reshape(B, S, FOX_W), w_o_fox)
    pos = jnp.arange(S, dtype=jnp.float32)
    qs = apply_rope(q_s.reshape(B, S, SWA_Q_HEADS, HEAD_DIM), pos)
    ks = apply_rope(k_s.reshape(B, S, SWA_KV_HEADS, HEAD_DIM), pos)
    o_s = sliding_window_sink_attention(qs, ks, v_s.reshape(B, S, SWA_KV_HEADS, HEAD_DIM), attn_sinks)
    o_s = jnp.einsum('bsc,cd->bsd', o_s.reshape(B, S, SWA_QW), w_o_swa)
    merged = jax.nn.sigmoid(g_f) * o_f + jax.nn.sigmoid(g_s) * o_s
    return jnp.einsum('bsd,de->bse', merged, w_out)


def swiglu_ffn(x, w_gate, w_up, w_down):
    h = jax.nn.silu(jnp.einsum('bsd,df->bsf', x, w_gate)) * jnp.einsum('bsd,df->bsf', x, w_up)
    return jnp.einsum('bsf,fd->bsd', h, w_down)


def setup_inputs(seed: int = 0) -> dict:
    key = jax.random.key(seed)
    ks = jax.random.split(key, 16)
    L = DEPTH
    nrm = jax.random.normal
    x = nrm(ks[0], (BATCH, SEQ, D_MODEL), jnp.float32)
    col_scale = jnp.concatenate([
        jnp.ones((2 * FOX_W,), jnp.float32),
        jnp.full((FOX_W,), DEEPNORM_BETA, jnp.float32),
        jnp.ones((FOX_HEADS + SWA_QW + SWA_KVW,), jnp.float32),
        jnp.full((SWA_KVW,), DEEPNORM_BETA, jnp.float32),
        jnp.ones((2 * D_MODEL,), jnp.float32)])
    w_in = nrm(ks[1], (L, D_MODEL, IN_COLS), jnp.float32) * (D_MODEL ** -0.5) * col_scale
    b_forget = 1.0 + 0.1 * nrm(ks[2], (L, FOX_HEADS), jnp.float32)
    attn_sinks = 0.5 * nrm(ks[3], (L, SWA_Q_HEADS), jnp.float32)
    w_o_fox = nrm(ks[4], (L, FOX_W, D_MODEL), jnp.float32) * (FOX_W ** -0.5)
    w_o_swa = nrm(ks[5], (L, SWA_QW, D_MODEL), jnp.float32) * (SWA_QW ** -0.5)
    w_out = nrm(ks[6], (L, D_MODEL, D_MODEL), jnp.float32) * (D_MODEL ** -0.5) * DEEPNORM_BETA
    ln1_g = 1.0 + 0.02 * nrm(ks[7], (L, D_MODEL), jnp.float32)
    ln1_b = 0.02 * nrm(ks[8], (L, D_MODEL), jnp.float32)
    w_gate = nrm(ks[9], (L, D_MODEL, D_FF), jnp.float32) * (D_MODEL ** -0.5)
    w_up = nrm(ks[10], (L, D_MODEL, D_FF), jnp.float32) * (D_MODEL ** -0.5)
    w_down = nrm(ks[11], (L, D_FF, D_MODEL), jnp.float32) * (D_FF ** -0.5) * DEEPNORM_BETA
    ln2_g = 1.0 + 0.02 * nrm(ks[12], (L, D_MODEL), jnp.float32)
    ln2_b = 0.02 * nrm(ks[13], (L, D_MODEL), jnp.float32)
    return {"x": x, "w_in": w_in, "b_forget": b_forget, "attn_sinks": attn_sinks,
            "w_o_fox": w_o_fox, "w_o_swa": w_o_swa, "w_out": w_out,
            "ln1_g": ln1_g, "ln1_b": ln1_b, "w_gate": w_gate, "w_up": w_up,
            "w_down": w_down, "ln2_g": ln2_g, "ln2_b": ln2_b}


def reference(x, w_in, b_forget, attn_sinks, w_o_fox, w_o_swa, w_out,
              ln1_g, ln1_b, w_gate, w_up, w_down, ln2_g, ln2_b):
    h = x
    for l in range(DEPTH):
        mix = hybrid_mixer(h, w_in[l], b_forget[l], attn_sinks[l], w_o_fox[l], w_o_swa[l], w_out[l])
        h = layer_norm(DEEPNORM_ALPHA * h + mix, ln1_g[l], ln1_b[l])
        ff = swiglu_ffn(h, w_gate[l], w_up[l], w_down[l])
        h = layer_norm(DEEPNORM_ALPHA * h + ff, ln2_g[l], ln2_b[l])
    return h
```

```cpp
#include <hip/hip_runtime.h>
#include <hip/hip_cooperative_groups.h>
#include <cstdio>
#include <cstdint>
namespace cg = cooperative_groups;

typedef unsigned short bf16_t;
typedef short bf16x8 __attribute__((ext_vector_type(8)));
typedef float f32x4 __attribute__((ext_vector_type(4)));
typedef float f32x2 __attribute__((ext_vector_type(2)));
typedef unsigned u32x4 __attribute__((ext_vector_type(4)));
typedef unsigned u32x2 __attribute__((ext_vector_type(2)));
typedef __bf16 bf16x2_t __attribute__((ext_vector_type(2)));

constexpr int BATCH = 32, SEQ = 2048, DM = 1024, M = BATCH * SEQ;
constexpr int NPROJ = 4352;
constexpr int INCOLS = 4360;
constexpr int DFF = 2816, NGU = 2 * DFF;
constexpr int NTHREADS = 512, NWAVES = 8;
constexpr float LOG2E = 1.4426950408889634f;
constexpr float C2 = 0.125f * LOG2E;
constexpr float ALPHA = 1.189207115002721f;
constexpr float LN_EPS = 1e-5f;
constexpr int LDS_BYTES = 147456;

constexpr size_t MiB = 1u << 20;
constexpr size_t WS_ROPE = 1 * MiB;
constexpr size_t WS_LOGF = 2 * MiB;
constexpr size_t WS_CL = 4 * MiB;
constexpr size_t WS_WIN = 8 * MiB;
constexpr size_t WS_WOF = 17 * MiB;
constexpr size_t WS_WOS = 18 * MiB;
constexpr size_t WS_WOUT = 19 * MiB;
constexpr size_t WS_WGU = 21 * MiB;
constexpr size_t WS_WD = 32 * MiB;
constexpr size_t WS_XB = 40 * MiB;
constexpr size_t WS_QF = 168 * MiB;
constexpr size_t WS_QS = 232 * MiB;
constexpr size_t WS_KF = 296 * MiB;
constexpr size_t WS_VF = 360 * MiB;
constexpr size_t WS_KS = 424 * MiB;
constexpr size_t WS_VS = 440 * MiB;
constexpr size_t WS_GF = 456 * MiB;
constexpr size_t WS_GS = 584 * MiB;
constexpr size_t WS_HM = 168 * MiB;
constexpr size_t WS_END = 712 * MiB;

__device__ __forceinline__ unsigned pk_bf16(float lo, float hi) { f32x2 v = {lo, hi}; bf16x2_t b = __builtin_convertvector(v, bf16x2_t); return __builtin_bit_cast(unsigned, b); }
__device__ __forceinline__ float bf_lo(unsigned w) { return __uint_as_float(w << 16); }
__device__ __forceinline__ float bf_hi(unsigned w) { return __uint_as_float(w & 0xffff0000u); }
__device__ __forceinline__ u32x4 pk8(f32x4 a, f32x4 b) { u32x4 w; w.x = pk_bf16(a[0], a[1]); w.y = pk_bf16(a[2], a[3]); w.z = pk_bf16(b[0], b[1]); w.w = pk_bf16(b[2], b[3]); return w; }
__device__ __forceinline__ void unpk8(u32x4 w, f32x4& a, f32x4& b) { a = (f32x4){bf_lo(w.x), bf_hi(w.x), bf_lo(w.y), bf_hi(w.y)}; b = (f32x4){bf_lo(w.z), bf_hi(w.z), bf_lo(w.w), bf_hi(w.w)}; }
__device__ __forceinline__ float wave_sum(float v) {
#pragma unroll
    for (int o = 1; o < 64; o <<= 1) v += __shfl_xor(v, o);
    return v;
}
__device__ __forceinline__ float sigmoidf_(float g) { return __builtin_amdgcn_rcpf(1.0f + __expf(-g)); }

__device__ __forceinline__ void sincos_acc(float a, float& c, float& s) {
    const double x = (double)a;
    const double k = __builtin_rint(x * 0.63661977236758134308);
    double r = __builtin_fma(-k, 1.57079632679489655800, x); r = __builtin_fma(-k, 6.12323399573676603587e-17, r);
    const int q = ((int)k) & 3;
    const double r2 = r * r;
    const double sn = r * (1.0 + r2 * (-1.0 / 6 + r2 * (1.0 / 120 + r2 * (-1.0 / 5040 + r2 * (1.0 / 362880 + r2 * (-1.0 / 39916800 + r2 * (1.0 / 6227020800.0)))))));
    const double cs = 1.0 + r2 * (-0.5 + r2 * (1.0 / 24 + r2 * (-1.0 / 720 + r2 * (1.0 / 40320 + r2 * (-1.0 / 3628800 + r2 * (1.0 / 479001600.0))))));
    double ss, cc;
    if (q == 0) { ss = sn; cc = cs; } else if (q == 1) { ss = cs; cc = -sn; } else if (q == 2) { ss = -sn; cc = -cs; } else { ss = -cs; cc = sn; }
    c = (float)cc; s = (float)ss;
}

template <class F> __device__ __forceinline__ void conv_w(int K, int N, int ldw, bf16_t* WT, const F& col, int gtid, int ngt) {
    const int nkb = K / 8; const int items = N * nkb;
    for (int it = gtid; it < items; it += ngt) {
        const int nb = it / (64 * nkb), rem = it - nb * (64 * nkb), kb = rem >> 6, n = nb * 64 + (rem & 63), k0 = kb * 8;
        const float* c = col(n) + (size_t)k0 * ldw;
        float v[8];
#pragma unroll
        for (int i = 0; i < 8; ++i) v[i] = c[(size_t)i * ldw];
        u32x4 w; w.x = pk_bf16(v[0], v[1]); w.y = pk_bf16(v[2], v[3]); w.z = pk_bf16(v[4], v[5]); w.w = pk_bf16(v[6], v[7]);
        *(u32x4*)(WT + (size_t)n * K + k0) = w;
    }
}
struct ColIn { const float* W;
    __device__ __forceinline__ const float* operator()(int n) const {
        int s;
        if (n < 512) s = n;
        else if (n < 1024) { const int r = n - 512, hh = r >> 6, p = r & 63; s = 1544 + hh * 64 + (p >> 1) + 32 * (p & 1); }
        else if (n < 1536) s = 512 + (n - 1024);
        else if (n < 2048) s = 1024 + (n - 1536);
        else if (n < 2176) { const int r = n - 2048, hh = r >> 6, p = r & 63; s = 2056 + hh * 64 + (p >> 1) + 32 * (p & 1); }
        else if (n < 2304) s = 2184 + (n - 2176);
        else if (n < 3328) s = 2312 + (n - 2304);
        else s = 3336 + (n - 3328);
        return W + s; } };
struct ColId { const float* W; __device__ __forceinline__ const float* operator()(int n) const { return W + n; } };
struct ColGU { const float* Wg; const float* Wu; __device__ __forceinline__ const float* operator()(int n) const { const int t = n >> 8, r = n & 255; return r < 128 ? Wg + 128 * t + r : Wu + 128 * t + (r - 128); } };

struct Gemm { const bf16_t* A[2]; const bf16_t* Bt[2]; int lda, ldb, K, nM, nN, nZ; };

template <class Epi> __device__ __forceinline__ void gemm_simple(const Gemm g, const Epi& E) {
    const int tid = threadIdx.x, wid = __builtin_amdgcn_readfirstlane(tid >> 6), lane = tid & 63, wr = wid >> 2, wc = wid & 3, fr = lane & 15, fq = lane >> 4;
    const int nunits = g.nM * g.nN;
    for (int u = blockIdx.x; u < nunits; u += gridDim.x) {
        const int pn = u % g.nN, pm = u / g.nN;
        for (int z = 0; z < g.nZ; ++z) {
            f32x4 acc[2][2][4][2];
#pragma unroll
            for (int a = 0; a < 2; ++a)
#pragma unroll
                for (int b = 0; b < 2; ++b)
#pragma unroll
                    for (int m = 0; m < 4; ++m)
#pragma unroll
                        for (int n = 0; n < 2; ++n) acc[a][b][m][n] = (f32x4){0.f, 0.f, 0.f, 0.f};
            const char* Abase = (const char*)(g.A[z] + (size_t)(pm * 256) * g.lda);
            const char* Bbase = (const char*)(g.Bt[z] + (size_t)(pn * 256) * g.ldb);
            const unsigned offA = (unsigned)((wr * 64 + fr) * g.lda + fq * 8) * 2u;
            const unsigned offB = (unsigned)((wc * 32 + 8 * (fr >> 2) + (fr & 3)) * g.ldb + fq * 8) * 2u;
#pragma unroll 1
            for (int kt = 0; kt < g.K; kt += 64) {
#pragma unroll
                for (int bj = 0; bj < 2; ++bj) {
                    bf16x8 Bf[2][2];
#pragma unroll
                    for (int n = 0; n < 2; ++n) { const char* rp = Bbase + (size_t)(bj * 128 + 4 * n) * g.ldb * 2 + kt * 2;
#pragma unroll
                        for (int k = 0; k < 2; ++k) Bf[n][k] = *(const bf16x8*)(rp + offB + 64 * k); }
#pragma unroll
                    for (int ai = 0; ai < 2; ++ai)
#pragma unroll
                        for (int m = 0; m < 4; ++m) {
                            bf16x8 Af[2]; const char* rp = Abase + (size_t)(ai * 128 + m * 16) * g.lda * 2 + kt * 2;
#pragma unroll
                            for (int k = 0; k < 2; ++k) Af[k] = *(const bf16x8*)(rp + offA + 64 * k);
#pragma unroll
                            for (int n = 0; n < 2; ++n)
#pragma unroll
                                for (int k = 0; k < 2; ++k) acc[ai][bj][m][n] = __builtin_amdgcn_mfma_f32_16x16x32_bf16(Bf[n][k], Af[k], acc[ai][bj][m][n], 0, 0, 0);
                        }
                }
            }
            E(acc, pm, pn, z, wr, wc, fr, fq);
        }
    }
}

struct EpiIn {
    bf16_t *QF, *QS, *KF, *VF, *KS, *VS, *GF, *GS; const float* rope;
    __device__ __forceinline__ void operator()(const f32x4 (&acc)[2][2][4][2], int pm, int pn, int z, int wr, int wc, int fr, int fq) const {
#pragma unroll
        for (int bj = 0; bj < 2; ++bj) {
            bf16_t* base; int ld, col, mode;
            if (pn < 2) { base = QF; ld = 512; col = pn * 256 + bj * 128; mode = 1; }
            else if (pn < 4) { base = QS; ld = 512; col = (pn - 2) * 256 + bj * 128; mode = 2; }
            else if (pn < 6) { base = KF; ld = 512; col = (pn - 4) * 256 + bj * 128; mode = 0; }
            else if (pn < 8) { base = VF; ld = 512; col = (pn - 6) * 256 + bj * 128; mode = 0; }
            else if (pn == 8) { if (bj == 0) { base = KS; mode = 3; } else { base = VS; mode = 0; } ld = 128; col = 0; }
            else if (pn < 13) { base = GF; ld = 1024; col = (pn - 9) * 256 + bj * 128; mode = 4; }
            else { base = GS; ld = 1024; col = (pn - 13) * 256 + bj * 128; mode = 4; }
            char* tb = (char*)(base + (size_t)(pm * 256) * ld + col);
            const unsigned lo = (unsigned)((wr * 64 + fr) * ld + wc * 32 + 8 * fq) * 2u;
            const int j0 = 16 * (wc & 1) + 4 * fq;
            const int pos0 = ((pm * 256) & (SEQ - 1)) + wr * 64 + fr;
#pragma unroll
            for (int ai = 0; ai < 2; ++ai)
#pragma unroll
                for (int m = 0; m < 4; ++m) {
                    f32x4 v0 = acc[ai][bj][m][0], v1 = acc[ai][bj][m][1];
                    if (mode == 2 || mode == 3) {
                        const int pos = pos0 + ai * 128 + m * 16;
                        const f32x4 t0 = *(const f32x4*)(rope + (size_t)(pos * 32 + j0) * 2), t1 = *(const f32x4*)(rope + (size_t)(pos * 32 + j0 + 2) * 2);
                        f32x4 r0, r1;
                        r0[0] = v0[0] * t0[0] - v0[1] * t0[1]; r0[1] = v0[1] * t0[0] + v0[0] * t0[1];
                        r0[2] = v0[2] * t0[2] - v0[3] * t0[3]; r0[3] = v0[3] * t0[2] + v0[2] * t0[3];
                        r1[0] = v1[0] * t1[0] - v1[1] * t1[1]; r1[1] = v1[1] * t1[0] + v1[0] * t1[1];
                        r1[2] = v1[2] * t1[2] - v1[3] * t1[3]; r1[3] = v1[3] * t1[2] + v1[2] * t1[3];
                        v0 = r0; v1 = r1;
                    }
                    if (mode == 1 || mode == 2) { v0 = v0 * C2; v1 = v1 * C2; }
                    if (mode == 4) {
#pragma unroll
                        for (int i = 0; i < 4; ++i) { v0[i] = sigmoidf_(v0[i]); v1[i] = sigmoidf_(v1[i]); }
                    }
                    *(u32x4*)(tb + (size_t)((ai * 128 + m * 16) * ld * 2) + lo) = pk8(v0, v1);
                }
        }
    }
};
struct EpiGate {
    const bf16_t *GF, *GS; bf16_t* MG;
    __device__ __forceinline__ void operator()(const f32x4 (&acc)[2][2][4][2], int pm, int pn, int z, int wr, int wc, int fr, int fq) const {
        const size_t tile = (size_t)(pm * 256) * 1024 + pn * 256;
        const char* gb = (const char*)((z ? GS : GF) + tile); char* mb = (char*)(MG + tile);
        const unsigned lo = (unsigned)((wr * 64 + fr) * 1024 + wc * 32 + 8 * fq) * 2u;
#pragma unroll
        for (int ai = 0; ai < 2; ++ai)
#pragma unroll
            for (int m = 0; m < 4; ++m)
#pragma unroll
                for (int bj = 0; bj < 2; ++bj) {
                    const size_t d = (size_t)((ai * 128 + m * 16) * 1024 + bj * 128) * 2;
                    f32x4 g0, g1; unpk8(*(const u32x4*)(gb + d + lo), g0, g1);
                    f32x4 v0 = acc[ai][bj][m][0] * g0, v1 = acc[ai][bj][m][1] * g1;
                    if (z) { f32x4 p0, p1; unpk8(*(const u32x4*)(mb + d + lo), p0, p1); v0 += p0; v1 += p1; }
                    *(u32x4*)(mb + d + lo) = pk8(v0, v1);
                    if (bj) asm volatile("" ::: "memory");
                }
    }
};
struct EpiRes {
    const float* R; float* Y;
    __device__ __forceinline__ void operator()(const f32x4 (&acc)[2][2][4][2], int pm, int pn, int z, int wr, int wc, int fr, int fq) const {
        const size_t tile = (size_t)(pm * 256) * 1024 + pn * 256;
        const char* rb = (const char*)(R + tile); char* yb = (char*)(Y + tile);
        const unsigned lo = (unsigned)((wr * 64 + fr) * 1024 + wc * 32 + 8 * fq) * 4u;
#pragma unroll
        for (int ai = 0; ai < 2; ++ai)
#pragma unroll
            for (int m = 0; m < 4; ++m)
#pragma unroll
                for (int bj = 0; bj < 2; ++bj) {
                    const size_t d = (size_t)((ai * 128 + m * 16) * 1024 + bj * 128) * 4;
                    const f32x4 r0 = *(const f32x4*)(rb + d + lo), r1 = *(const f32x4*)(rb + d + lo + 16);
                    *(f32x4*)(yb + d + lo) = r0 * ALPHA + acc[ai][bj][m][0]; *(f32x4*)(yb + d + lo + 16) = r1 * ALPHA + acc[ai][bj][m][1];
                    if (bj) asm volatile("" ::: "memory");
                }
    }
};
struct EpiSwiglu {
    bf16_t* HM;
    __device__ __forceinline__ void operator()(const f32x4 (&acc)[2][2][4][2], int pm, int pn, int z, int wr, int wc, int fr, int fq) const {
        char* hb = (char*)(HM + (size_t)(pm * 256) * DFF + pn * 128);
        const unsigned lo = (unsigned)((wr * 64 + fr) * DFF + wc * 32 + 8 * fq) * 2u;
#pragma unroll
        for (int ai = 0; ai < 2; ++ai)
#pragma unroll
            for (int m = 0; m < 4; ++m) {
                f32x4 h0, h1;
#pragma unroll
                for (int i = 0; i < 4; ++i) { const float g0 = acc[ai][0][m][0][i], g1 = acc[ai][0][m][1][i];
                    h0[i] = g0 * sigmoidf_(g0) * acc[ai][1][m][0][i]; h1[i] = g1 * sigmoidf_(g1) * acc[ai][1][m][1][i]; }
                *(u32x4*)(hb + (size_t)((ai * 128 + m * 16) * DFF * 2) + lo) = pk8(h0, h1);
            }
    }
};

__device__ __forceinline__ void ln_rows(float* Y, const float* gam, const float* bet, bf16_t* HB, int gw, int ngw, int lane) {
    f32x4 gv[4], bv[4];
#pragma unroll
    for (int j = 0; j < 4; ++j) { gv[j] = *((const f32x4*)gam + lane + 64 * j); bv[j] = *((const f32x4*)bet + lane + 64 * j); }
    for (int m = gw; m < M; m += ngw) {
        f32x4* yr = (f32x4*)(Y + (size_t)m * DM) + lane;
        f32x4 v[4]; float s = 0.f;
#pragma unroll
        for (int j = 0; j < 4; ++j) { v[j] = yr[64 * j]; s += (v[j][0] + v[j][1]) + (v[j][2] + v[j][3]); }
        const float mean = wave_sum(s) * (1.f / DM); float s2 = 0.f;
#pragma unroll
        for (int j = 0; j < 4; ++j) { v[j] = v[j] - mean; s2 += (v[j][0] * v[j][0] + v[j][1] * v[j][1]) + (v[j][2] * v[j][2] + v[j][3] * v[j][3]); }
        const float rstd = 1.f / sqrtf(wave_sum(s2) * (1.f / DM) + LN_EPS);
#pragma unroll
        for (int j = 0; j < 4; ++j) {
            const f32x4 o = v[j] * rstd * gv[j] + bv[j];
            yr[64 * j] = o;
            if (HB) { u32x2 w; w.x = pk_bf16(o[0], o[1]); w.y = pk_bf16(o[2], o[3]); *((u32x2*)(HB + (size_t)m * DM) + lane + 64 * j) = w; }
        }
    }
}

template <int MODE> __device__ __forceinline__ void attn_simple(bf16_t* Q, const bf16_t* K, const bf16_t* V, const float* CL, const float* sinks, int gw, int ngw, int lane) {
    constexpr int KLD = MODE == 0 ? 512 : 128;
    for (int i = 0;; ++i) {
        const int u = gw + i * ngw; if (u >= 8192) break;
        const int bh = u >> 5; int qk = u & 31; if (i & 1) qk = 31 - qk;
        const int b = bh >> 3, h = bh & 7, kh = MODE == 0 ? h : (h >> 2);
        const int q = qk * 64 + lane;
        bf16_t* qp = Q + (size_t)(b * SEQ + q) * 512 + h * 64;
        float qv[64], o[64];
#pragma unroll
        for (int c = 0; c < 8; ++c) { const u32x4 w = *((const u32x4*)qp + c);
            qv[8 * c + 0] = bf_lo(w.x); qv[8 * c + 1] = bf_hi(w.x); qv[8 * c + 2] = bf_lo(w.y); qv[8 * c + 3] = bf_hi(w.y);
            qv[8 * c + 4] = bf_lo(w.z); qv[8 * c + 5] = bf_hi(w.z); qv[8 * c + 6] = bf_lo(w.w); qv[8 * c + 7] = bf_hi(w.w); }
#pragma unroll
        for (int d = 0; d < 64; ++d) o[d] = 0.f;
        float mx, l, cli = 0.f;
        if (MODE == 0) { mx = -INFINITY; l = 0.f; cli = CL[bh * SEQ + q]; } else { mx = sinks[h] * LOG2E; l = 1.f; }
        const int jlo = MODE == 0 ? 0 : (qk * 64 - 127 > 0 ? qk * 64 - 127 : 0), jhi = qk * 64 + 63;
        const bf16_t* kb = K + (size_t)(b * SEQ) * KLD + kh * 64;
        const bf16_t* vb = V + (size_t)(b * SEQ) * KLD + kh * 64;
        for (int j = jlo; j <= jhi; ++j) {
            const u32x4* kr = (const u32x4*)(kb + (size_t)j * KLD);
            float s = 0.f;
#pragma unroll
            for (int c = 0; c < 8; ++c) { const u32x4 w = kr[c];
                s += qv[8 * c + 0] * bf_lo(w.x) + qv[8 * c + 1] * bf_hi(w.x) + qv[8 * c + 2] * bf_lo(w.y) + qv[8 * c + 3] * bf_hi(w.y)
                   + qv[8 * c + 4] * bf_lo(w.z) + qv[8 * c + 5] * bf_hi(w.z) + qv[8 * c + 6] * bf_lo(w.w) + qv[8 * c + 7] * bf_hi(w.w); }
            bool act;
            if (MODE == 0) { s += cli - CL[bh * SEQ + j]; act = j <= q; } else { act = (j <= q) && (q - j < 128); }
            if (act) {
                const float mn = fmaxf(mx, s), sc = exp2f(mx - mn), p = exp2f(s - mn);
                mx = mn; l = l * sc + p;
                const u32x4* vr = (const u32x4*)(vb + (size_t)j * KLD);
#pragma unroll
                for (int c = 0; c < 8; ++c) { const u32x4 w = vr[c];
                    o[8 * c + 0] = o[8 * c + 0] * sc + p * bf_lo(w.x); o[8 * c + 1] = o[8 * c + 1] * sc + p * bf_hi(w.x);
                    o[8 * c + 2] = o[8 * c + 2] * sc + p * bf_lo(w.y); o[8 * c + 3] = o[8 * c + 3] * sc + p * bf_hi(w.y);
                    o[8 * c + 4] = o[8 * c + 4] * sc + p * bf_lo(w.z); o[8 * c + 5] = o[8 * c + 5] * sc + p * bf_hi(w.z);
                    o[8 * c + 6] = o[8 * c + 6] * sc + p * bf_lo(w.w); o[8 * c + 7] = o[8 * c + 7] * sc + p * bf_hi(w.w); }
            }
        }
        const float rl = 1.f / l;
#pragma unroll
        for (int c = 0; c < 8; ++c) { u32x4 w;
            w.x = pk_bf16(o[8 * c + 0] * rl, o[8 * c + 1] * rl); w.y = pk_bf16(o[8 * c + 2] * rl, o[8 * c + 3] * rl);
            w.z = pk_bf16(o[8 * c + 4] * rl, o[8 * c + 5] * rl); w.w = pk_bf16(o[8 * c + 6] * rl, o[8 * c + 7] * rl);
            *((u32x4*)qp + c) = w; }
    }
}

struct Params { const float* in[14]; float* out; unsigned char* ws; };

__global__ void __launch_bounds__(NTHREADS, 2) fwd_kernel(Params p) {
    extern __shared__ __attribute__((aligned(16))) unsigned char lds[];
    cg::grid_group grid = cg::this_grid();
    const int tid = threadIdx.x, lane = tid & 63, wid = __builtin_amdgcn_readfirstlane(tid >> 6);
    const int gw = blockIdx.x * NWAVES + wid, ngw = gridDim.x * NWAVES;
    const int gtid = blockIdx.x * NTHREADS + tid, ngt = gridDim.x * NTHREADS;
    unsigned char* ws = p.ws;
    const float *x = p.in[0], *w_in = p.in[1], *b_forget = p.in[2], *sinks = p.in[3], *w_o_fox = p.in[4], *w_o_swa = p.in[5], *w_out = p.in[6],
                *ln1_g = p.in[7], *ln1_b = p.in[8], *w_gate = p.in[9], *w_up = p.in[10], *w_down = p.in[11], *ln2_g = p.in[12], *ln2_b = p.in[13];
    float* rope = (float*)(ws + WS_ROPE); float* logf_ = (float*)(ws + WS_LOGF); float* CL = (float*)(ws + WS_CL);
    bf16_t *WIN = (bf16_t*)(ws + WS_WIN), *WOF = (bf16_t*)(ws + WS_WOF), *WOS = (bf16_t*)(ws + WS_WOS), *WOUT = (bf16_t*)(ws + WS_WOUT), *WGU = (bf16_t*)(ws + WS_WGU), *WD = (bf16_t*)(ws + WS_WD);
    bf16_t *XB = (bf16_t*)(ws + WS_XB), *QF = (bf16_t*)(ws + WS_QF), *QS = (bf16_t*)(ws + WS_QS), *KF = (bf16_t*)(ws + WS_KF), *VF = (bf16_t*)(ws + WS_VF),
           *KS = (bf16_t*)(ws + WS_KS), *VS = (bf16_t*)(ws + WS_VS), *GF = (bf16_t*)(ws + WS_GF), *GS = (bf16_t*)(ws + WS_GS), *HM = (bf16_t*)(ws + WS_HM);

    conv_w(DM, NPROJ, INCOLS, WIN, ColIn{w_in}, gtid, ngt);
    conv_w(512, DM, DM, WOF, ColId{w_o_fox}, gtid, ngt);
    conv_w(512, DM, DM, WOS, ColId{w_o_swa}, gtid, ngt);
    conv_w(DM, DM, DM, WOUT, ColId{w_out}, gtid, ngt);
    conv_w(DM, NGU, DFF, WGU, ColGU{w_gate, w_up}, gtid, ngt);
    conv_w(DFF, DM, DM, WD, ColId{w_down}, gtid, ngt);
    for (int it = gtid; it < SEQ * 32; it += ngt) {
        const int pos = it >> 5, j = it & 31;
        const float inv_freq = exp2f(-(float)j * (13.287712379549449f / 32.f));
        const float ang = (float)pos * inv_freq;
        float c, s; sincos_acc(ang, c, s);
        rope[2 * it] = c; rope[2 * it + 1] = s;
    }
#ifndef NO_P0
    {
        f32x4 wf[4][4][2];
#pragma unroll
        for (int j = 0; j < 4; ++j)
#pragma unroll
            for (int e = 0; e < 4; ++e) { const float* wp = w_in + (size_t)(256 * j + 4 * lane + e) * INCOLS + 1536; wf[j][e][0] = *(const f32x4*)wp; wf[j][e][1] = *(const f32x4*)(wp + 4); }
        const float bfv = b_forget[lane & 7];
        for (int m = gw; m < M; m += ngw) {
            const f32x4* xr = (const f32x4*)(x + (size_t)m * DM) + lane;
            f32x4 a0 = {0.f, 0.f, 0.f, 0.f}, a1 = {0.f, 0.f, 0.f, 0.f};
#pragma unroll
            for (int j = 0; j < 4; ++j) { const f32x4 v = xr[64 * j];
                u32x2 w; w.x = pk_bf16(v[0], v[1]); w.y = pk_bf16(v[2], v[3]); *((u32x2*)(XB + (size_t)m * DM) + lane + 64 * j) = w;
#pragma unroll
                for (int e = 0; e < 4; ++e) { a0 += wf[j][e][0] * v[e]; a1 += wf[j][e][1] * v[e]; } }
            float r[8] = {a0[0], a0[1], a0[2], a0[3], a1[0], a1[1], a1[2], a1[3]};
#pragma unroll
            for (int hh = 0; hh < 8; ++hh) r[hh] = wave_sum(r[hh]);
            float mine = r[0];
#pragma unroll
            for (int hh = 1; hh < 8; ++hh) mine = (lane & 7) == hh ? r[hh] : mine;
            if (lane < 8) { const float zz = mine + bfv; logf_[(size_t)m * 8 + lane] = fminf(zz, 0.f) - log1pf(__expf(-fabsf(zz))); }
        }
    }
#endif
    grid.sync();

    {
        double* sc = (double*)lds;
        for (int seq = blockIdx.x; seq < BATCH * 8; seq += gridDim.x) {
            const int b = seq >> 3, h = seq & 7;
            double v[4]; double s = 0.0;
#pragma unroll
            for (int e = 0; e < 4; ++e) { v[e] = (double)logf_[(size_t)(b * SEQ + tid * 4 + e) * 8 + h]; s += v[e]; }
            __syncthreads();
            sc[tid] = s;
            __syncthreads();
            double pre = 0.0;
            for (int i = 0; i < tid; ++i) pre += sc[i];
#pragma unroll
            for (int e = 0; e < 4; ++e) { pre += v[e]; CL[(size_t)seq * SEQ + tid * 4 + e] = (float)(pre * 1.4426950408889634); }
        }
        __syncthreads();
        Gemm g{{XB, XB}, {WIN, WIN}, DM, DM, DM, M / 256, NPROJ / 256, 1};
#ifndef NO_P1
        gemm_simple(g, EpiIn{QF, QS, KF, VF, KS, VS, GF, GS, rope});
#endif
    }
    grid.sync();

#ifndef NO_ATT
    attn_simple<0>(QF, KF, VF, CL, sinks, gw, ngw, lane);
    attn_simple<1>(QS, KS, VS, CL, sinks, gw, ngw, lane);
#endif
    grid.sync();

    { Gemm g{{QF, QS}, {WOF, WOS}, 512, 512, 512, M / 256, DM / 256, 2}; gemm_simple(g, EpiGate{GF, GS, XB}); }
    grid.sync();

    { Gemm g{{XB, XB}, {WOUT, WOUT}, DM, DM, DM, M / 256, DM / 256, 1}; gemm_simple(g, EpiRes{x, p.out}); }
    grid.sync();
    ln_rows(p.out, ln1_g, ln1_b, XB, gw, ngw, lane);
    grid.sync();

    { Gemm g{{XB, XB}, {WGU, WGU}, DM, DM, DM, M / 256, NGU / 256, 1}; gemm_simple(g, EpiSwiglu{HM}); }
    grid.sync();

    { Gemm g{{HM, HM}, {WD, WD}, DFF, DFF, DFF, M / 256, DM / 256, 1}; gemm_simple(g, EpiRes{p.out, p.out}); }
    grid.sync();
    ln_rows(p.out, ln2_g, ln2_b, nullptr, gw, ngw, lane);
}

extern "C" void kernel_launch(void* const* d_in, const int* in_sizes, int n_in, void* d_out, int out_size, void* d_ws, size_t ws_size, hipStream_t stream) {
    static int grid_blocks = 0;
    if (grid_blocks == 0) {
        if (n_in != 14 || out_size != M * DM || ws_size < WS_END) { fprintf(stderr, "kernel_launch: unexpected shapes (n_in %d out %d ws %zu)\n", n_in, out_size, ws_size); grid_blocks = -1; return; }
        int dev = 0, cus = 0, per_cu = 0;
        hipGetDevice(&dev);
        hipDeviceGetAttribute(&cus, hipDeviceAttributeMultiprocessorCount, dev);
        hipFuncSetAttribute((const void*)fwd_kernel, hipFuncAttributeMaxDynamicSharedMemorySize, LDS_BYTES);
        hipOccupancyMaxActiveBlocksPerMultiprocessor(&per_cu, (const void*)fwd_kernel, NTHREADS, LDS_BYTES);
        if (per_cu < 1) { fprintf(stderr, "kernel_launch: occupancy query says %d blocks per CU\n", per_cu); per_cu = 1; }
        (void)hipGetLastError();
        grid_blocks = cus * 1;
    }
    if (grid_blocks < 0) return;
    Params p{};
    for (int i = 0; i < 14; ++i) p.in[i] = (const float*)d_in[i];
    p.out = (float*)d_out; p.ws = (unsigned char*)d_ws;
    void* args[] = {&p};
    hipError_t e = hipLaunchCooperativeKernel((const void*)fwd_kernel, dim3(grid_blocks), dim3(NTHREADS), args, LDS_BYTES, stream);
    if (e != hipSuccess) fprintf(stderr, "cooperative launch failed: %s (grid %d)\n", hipGetErrorString(e), grid_blocks);
}
```

```cpp
#include <hip/hip_runtime.h>
#include <hip/hip_cooperative_groups.h>
#include <cstdio>
#include <cstdint>
namespace cg = cooperative_groups;

typedef unsigned short bf16_t;
typedef short bf16x8 __attribute__((ext_vector_type(8)));
typedef float f32x4 __attribute__((ext_vector_type(4)));
typedef float f32x2 __attribute__((ext_vector_type(2)));
typedef unsigned u32x4 __attribute__((ext_vector_type(4)));
typedef unsigned u32x2 __attribute__((ext_vector_type(2)));
typedef __bf16 bf16x2_t __attribute__((ext_vector_type(2)));

constexpr int BATCH = 32, SEQ = 2048, DM = 1024, M = BATCH * SEQ;
constexpr int NPROJ = 4352;
constexpr int INCOLS = 4360;
constexpr int DFF = 2816, NGU = 2 * DFF;
constexpr int NTHREADS = 512, NWAVES = 8;
constexpr float LOG2E = 1.4426950408889634f;
constexpr float C2 = 0.125f * LOG2E;
constexpr float ALPHA = 1.189207115002721f;
constexpr float LN_EPS = 1e-5f;
constexpr int LDS_BYTES = 147456;

constexpr size_t MiB = 1u << 20;
constexpr size_t WS_ROPE = 1 * MiB;
constexpr size_t WS_LOGF = 2 * MiB;
constexpr size_t WS_CL = 4 * MiB;
constexpr size_t WS_WIN = 8 * MiB;
constexpr size_t WS_WOF = 17 * MiB;
constexpr size_t WS_WOS = 18 * MiB;
constexpr size_t WS_WOUT = 19 * MiB;
constexpr size_t WS_WGU = 21 * MiB;
constexpr size_t WS_WD = 32 * MiB;
constexpr size_t WS_XB = 40 * MiB;
constexpr size_t WS_QF = 168 * MiB;
constexpr size_t WS_QS = 232 * MiB;
constexpr size_t WS_KF = 296 * MiB;
constexpr size_t WS_VF = 360 * MiB;
constexpr size_t WS_KS = 424 * MiB;
constexpr size_t WS_VS = 440 * MiB;
constexpr size_t WS_GF = 456 * MiB;
constexpr size_t WS_GS = 584 * MiB;
constexpr size_t WS_HM = 168 * MiB;
constexpr size_t WS_END = 712 * MiB;

__device__ __forceinline__ unsigned pk_bf16(float lo, float hi) { f32x2 v = {lo, hi}; bf16x2_t b = __builtin_convertvector(v, bf16x2_t); return __builtin_bit_cast(unsigned, b); }
__device__ __forceinline__ float bf_lo(unsigned w) { return __uint_as_float(w << 16); }
__device__ __forceinline__ float bf_hi(unsigned w) { return __uint_as_float(w & 0xffff0000u); }
__device__ __forceinline__ u32x4 pk8(f32x4 a, f32x4 b) { u32x4 w; w.x = pk_bf16(a[0], a[1]); w.y = pk_bf16(a[2], a[3]); w.z = pk_bf16(b[0], b[1]); w.w = pk_bf16(b[2], b[3]); return w; }
__device__ __forceinline__ void unpk8(u32x4 w, f32x4& a, f32x4& b) { a = (f32x4){bf_lo(w.x), bf_hi(w.x), bf_lo(w.y), bf_hi(w.y)}; b = (f32x4){bf_lo(w.z), bf_hi(w.z), bf_lo(w.w), bf_hi(w.w)}; }
__device__ __forceinline__ float wave_sum(float v) {
#pragma unroll
    for (int o = 1; o < 64; o <<= 1) v += __shfl_xor(v, o);
    return v;
}
__device__ __forceinline__ float sigmoidf_(float g) { return __builtin_amdgcn_rcpf(1.0f + __expf(-g)); }

__device__ __forceinline__ void sincos_acc(float a, float& c, float& s) {
    const double x = (double)a;
    const double k = __builtin_rint(x * 0.63661977236758134308);
    double r = __builtin_fma(-k, 1.57079632679489655800, x); r = __builtin_fma(-k, 6.12323399573676603587e-17, r);
    const int q = ((int)k) & 3;
    const double r2 = r * r;
    const double sn = r * (1.0 + r2 * (-1.0 / 6 + r2 * (1.0 / 120 + r2 * (-1.0 / 5040 + r2 * (1.0 / 362880 + r2 * (-1.0 / 39916800 + r2 * (1.0 / 6227020800.0)))))));
    const double cs = 1.0 + r2 * (-0.5 + r2 * (1.0 / 24 + r2 * (-1.0 / 720 + r2 * (1.0 / 40320 + r2 * (-1.0 / 3628800 + r2 * (1.0 / 479001600.0))))));
    double ss, cc;
    if (q == 0) { ss = sn; cc = cs; } else if (q == 1) { ss = cs; cc = -sn; } else if (q == 2) { ss = -sn; cc = -cs; } else { ss = -cs; cc = sn; }
    c = (float)cc; s = (float)ss;
}

template <class F> __device__ __forceinline__ void conv_w(int K, int N, int ldw, bf16_t* WT, const F& col, int gtid, int ngt) {
    const int nkb = K / 8; const int items = N * nkb;
    for (int it = gtid; it < items; it += ngt) {
        const int nb = it / (64 * nkb), rem = it - nb * (64 * nkb), kb = rem >> 6, n = nb * 64 + (rem & 63), k0 = kb * 8;
        const float* c = col(n) + (size_t)k0 * ldw;
        float v[8];
#pragma unroll
        for (int i = 0; i < 8; ++i) v[i] = c[(size_t)i * ldw];
        u32x4 w; w.x = pk_bf16(v[0], v[1]); w.y = pk_bf16(v[2], v[3]); w.z = pk_bf16(v[4], v[5]); w.w = pk_bf16(v[6], v[7]);
        *(u32x4*)(WT + (size_t)n * K + k0) = w;
    }
}
struct ColIn { const float* W;
    __device__ __forceinline__ const float* operator()(int n) const {
        int s;
        if (n < 512) s = n;
        else if (n < 1024) { const int r = n - 512, hh = r >> 6, p = r & 63; s = 1544 + hh * 64 + (p >> 1) + 32 * (p & 1); }
        else if (n < 1536) s = 512 + (n - 1024);
        else if (n < 2048) s = 1024 + (n - 1536);
        else if (n < 2176) { const int r = n - 2048, hh = r >> 6, p = r & 63; s = 2056 + hh * 64 + (p >> 1) + 32 * (p & 1); }
        else if (n < 2304) s = 2184 + (n - 2176);
        else if (n < 3328) s = 2312 + (n - 2304);
        else s = 3336 + (n - 3328);
        return W + s; } };
struct ColId { const float* W; __device__ __forceinline__ const float* operator()(int n) const { return W + n; } };
struct ColGU { const float* Wg; const float* Wu; __device__ __forceinline__ const float* operator()(int n) const { const int t = n >> 8, r = n & 255; return r < 128 ? Wg + 128 * t + r : Wu + 128 * t + (r - 128); } };

struct Gemm { const bf16_t *A0, *A1, *B0, *B1; int lda, ldb, K, nM, nN, nZ; };

template <class Epi> __device__ __forceinline__ void gemm_simple(const Gemm g, const Epi& E) {
    const int tid = threadIdx.x, wid = __builtin_amdgcn_readfirstlane(tid >> 6), lane = tid & 63, wr = wid >> 2, wc = wid & 3, fr = lane & 15, fq = lane >> 4;
    const int nunits = g.nM * g.nN;
    for (int u = blockIdx.x; u < nunits; u += gridDim.x) {
        const int pn = u % g.nN, pm = u / g.nN;
        for (int z = 0; z < g.nZ; ++z) {
            f32x4 acc[2][2][4][2];
#pragma unroll
            for (int a = 0; a < 2; ++a)
#pragma unroll
                for (int b = 0; b < 2; ++b)
#pragma unroll
                    for (int m = 0; m < 4; ++m)
#pragma unroll
                        for (int n = 0; n < 2; ++n) acc[a][b][m][n] = (f32x4){0.f, 0.f, 0.f, 0.f};
            const char* Abase = (const char*)((z ? g.A1 : g.A0) + (size_t)(pm * 256) * g.lda);
            const char* Bbase = (const char*)((z ? g.B1 : g.B0) + (size_t)(pn * 256) * g.ldb);
            const unsigned offA = (unsigned)((wr * 64 + fr) * g.lda + fq * 8) * 2u;
            const unsigned offB = (unsigned)((wc * 32 + 8 * (fr >> 2) + (fr & 3)) * g.ldb + fq * 8) * 2u;
#pragma unroll 1
            for (int kt = 0; kt < g.K; kt += 64) {
#pragma unroll
                for (int bj = 0; bj < 2; ++bj) {
                    bf16x8 Bf[2][2];
#pragma unroll
                    for (int n = 0; n < 2; ++n) { const char* rp = Bbase + (size_t)(bj * 128 + 4 * n) * g.ldb * 2 + kt * 2;
#pragma unroll
                        for (int k = 0; k < 2; ++k) Bf[n][k] = *(const bf16x8*)(rp + offB + 64 * k); }
#pragma unroll
                    for (int ai = 0; ai < 2; ++ai)
#pragma unroll
                        for (int m = 0; m < 4; ++m) {
                            bf16x8 Af[2]; const char* rp = Abase + (size_t)(ai * 128 + m * 16) * g.lda * 2 + kt * 2;
#pragma unroll
                            for (int k = 0; k < 2; ++k) Af[k] = *(const bf16x8*)(rp + offA + 64 * k);
#pragma unroll
                            for (int n = 0; n < 2; ++n)
#pragma unroll
                                for (int k = 0; k < 2; ++k) acc[ai][bj][m][n] = __builtin_amdgcn_mfma_f32_16x16x32_bf16(Bf[n][k], Af[k], acc[ai][bj][m][n], 0, 0, 0);
                        }
                }
            }
            E(acc, pm, pn, z, wr, wc, fr, fq);
        }
    }
}

#define PG8_LAS __attribute__((address_space(3)))
namespace pg8 {
constexpr int BM = 256, BK = 64, HALF = 128, HTB = HALF * BK * 2, STAGE_BYTES = 8 * HTB, NXCD = 8, WGM = 8;
__device__ __forceinline__ int lds_byte(int r, int c) { const int st = (r >> 4) * 2 + (c >> 5), rr = r & 15, cc = c & 31, ob = rr * 64 + cc * 2; return st * 1024 + (ob ^ (((ob >> 9) & 1) << 5)); }
__device__ __forceinline__ void stage_rc(int b, int& R, int& C) { const int st = b / 1024, sb = b % 1024, swz = sb ^ (((sb >> 9) & 1) << 5); R = (st >> 1) * 16 + swz / 64; C = (st & 1) * 32 + (swz % 64) / 2; }
__device__ __forceinline__ int perm32(int rho) { const int n = rho >> 4, i = rho & 15; return 8 * (i >> 2) + 4 * n + (i & 3); }
struct Unit { int pm, pn, z; };
struct Order {
    int nM, nN, nwg, G, c, nZ;
    __device__ __forceinline__ void init(int nM_, int nN_, int nZ_, int G_, int c_) { nM = nM_; nN = nN_; nwg = nM * nN; G = G_; c = c_; nZ = nZ_; }
    __device__ __forceinline__ bool next(int i, Unit& u) const {
        const int ti = i / nZ; u.z = i - ti * nZ;
        const long L = (long)ti * G + c; if (L >= nwg) return false;
        int wgid = (int)L; { const int q = nwg / NXCD, r = nwg % NXCD, xcd = wgid % NXCD, off = wgid / NXCD; wgid = (xcd < r ? xcd * (q + 1) : r * (q + 1) + (xcd - r) * q) + off; }
        const int nig = WGM * nN, gid = wgid / nig, fm = gid * WGM, gsz = (nM - fm) < WGM ? (nM - fm) : WGM;
        u.pm = fm + ((wgid % nig) % gsz); u.pn = (wgid % nig) / gsz; return true;
    }
};
template <class Epi>
__device__ __forceinline__ void gemm_phase(PG8_LAS unsigned char* lds, const Gemm g, const Order& S, const Epi& E) {
    const int tid = threadIdx.x, wid = __builtin_amdgcn_readfirstlane(tid >> 6), lane = tid & 63, wr = wid >> 2, wc = wid & 3, fr = lane & 15, fq = lane >> 4;
    const int K = g.K, nt = K / BK;
    unsigned voffA[2], voffB[2];
#pragma unroll
    for (int i = 0; i < 2; ++i) { int R, C; stage_rc(tid * 16 + i * 8192, R, C); const int Rb = (R & ~31) + perm32(R & 31);
        voffA[i] = (unsigned)(R * K + C) * 2u; voffB[i] = (unsigned)(Rb * K + C) * 2u; }
    const size_t kstep = (size_t)(BK * 2);
    const size_t hstep = (size_t)HALF * K * 2;
    const size_t tstep = 2 * hstep;
    const unsigned ldsw = (unsigned)wid * 1024u;
    const int aoff = lds_byte(wr * 64 + fr, fq * 8), boff = lds_byte(wc * 32 + fr, fq * 8);
#define PG8_SA(b, h) (((b) * 2 + (h)) * HTB)
#define PG8_SB(b, h) ((4 + (b) * 2 + (h)) * HTB)
#define PG8_STAGE(bufoff, gbase, voff) do { _Pragma("unroll") for (int _i = 0; _i < 2; ++_i) \
        __builtin_amdgcn_global_load_lds((const unsigned*)((const char*)(gbase) + (voff)[_i]), (PG8_LAS unsigned*)(lds + (bufoff) + ldsw + _i * 8192), 16, 0, 0); } while (0)
#define PG8_LDA(dst, b, h) do { _Pragma("unroll") for (int m = 0; m < 4; ++m) _Pragma("unroll") for (int k = 0; k < 2; ++k) dst[m][k] = *(const PG8_LAS bf16x8*)(lds + PG8_SA(b, h) + aoff + m * 2048 + k * 1024); } while (0)
#define PG8_LDB(dst, b, h) do { _Pragma("unroll") for (int n = 0; n < 2; ++n) _Pragma("unroll") for (int k = 0; k < 2; ++k) dst[n][k] = *(const PG8_LAS bf16x8*)(lds + PG8_SB(b, h) + boff + n * 2048 + k * 1024); } while (0)
#define PG8_MMA(ai, bj, At, Bt) do { __builtin_amdgcn_s_setprio(1); _Pragma("unroll") for (int m = 0; m < 4; ++m) _Pragma("unroll") for (int n = 0; n < 2; ++n) _Pragma("unroll") for (int k = 0; k < 2; ++k) \
        acc[ai][bj][m][n] = __builtin_amdgcn_mfma_f32_16x16x32_bf16(Bt[n][k], At[m][k], acc[ai][bj][m][n], 0, 0, 0); __builtin_amdgcn_s_setprio(0); } while (0)
#define PG8_WAIT_V(n) asm volatile("s_waitcnt vmcnt(" #n ")" ::: "memory")
#define PG8_WAIT_L(n) asm volatile("s_waitcnt lgkmcnt(" #n ")" ::: "memory")
#define PG8_BAR __builtin_amdgcn_s_barrier()
#define PG8_SCHED __builtin_amdgcn_sched_barrier(0)
    Unit cur, nxt; int ui = 0;
    if (!S.next(0, cur)) return;
    f32x4 acc[2][2][4][2];
#pragma unroll
    for (int a = 0; a < 2; ++a)
#pragma unroll
        for (int b = 0; b < 2; ++b)
#pragma unroll
            for (int m = 0; m < 4; ++m)
#pragma unroll
                for (int n = 0; n < 2; ++n) acc[a][b][m][n] = (f32x4){0.f, 0.f, 0.f, 0.f};
    bf16x8 At[4][2], B0[2][2], B1[2][2];
    const char* cA = (const char*)(cur.z ? g.A1 : g.A0) + (size_t)cur.pm * tstep; const char* cB = (const char*)(cur.z ? g.B1 : g.B0) + (size_t)cur.pn * tstep;
    PG8_STAGE(PG8_SB(0, 0), cB, voffB); PG8_STAGE(PG8_SB(0, 1), cB + hstep, voffB); PG8_STAGE(PG8_SA(0, 0), cA, voffA); PG8_STAGE(PG8_SA(0, 1), cA + hstep, voffA);
    if (wr == 1) PG8_BAR;
    PG8_WAIT_V(2); PG8_BAR;
    PG8_STAGE(PG8_SB(1, 0), cB + kstep, voffB); PG8_STAGE(PG8_SA(1, 0), cA + kstep, voffA); PG8_STAGE(PG8_SB(1, 1), cB + hstep + kstep, voffB);
    PG8_WAIT_V(6); PG8_BAR;
    for (;;) {
        const bool has_next = S.next(ui + 1, nxt);
        const char* nA = has_next ? (const char*)(nxt.z ? g.A1 : g.A0) + (size_t)nxt.pm * tstep : cA; const char* nB = has_next ? (const char*)(nxt.z ? g.B1 : g.B0) + (size_t)nxt.pn * tstep : cB;
        for (int t = 0; t < nt; t += 2) {
            const bool last = (t == nt - 2);
            const char* a1 = cA + (size_t)(t + 1) * kstep;
            const char* a2 = last ? nA : cA + (size_t)(t + 2) * kstep; const char* b2 = last ? nB : cB + (size_t)(t + 2) * kstep;
            const char* a3 = a2 + kstep; const char* b3 = b2 + kstep;
            PG8_LDB(B0, 0, 0); PG8_LDB(B1, 0, 1); PG8_SCHED; PG8_LDA(At, 0, 0); PG8_STAGE(PG8_SA(1, 1), a1 + hstep, voffA);
            PG8_WAIT_V(8); PG8_WAIT_L(0); PG8_BAR; PG8_MMA(0, 0, At, B0); PG8_MMA(0, 1, At, B1); PG8_BAR; PG8_SCHED;
            PG8_LDA(At, 0, 1); PG8_STAGE(PG8_SB(0, 0), b2, voffB); PG8_STAGE(PG8_SB(0, 1), b2 + hstep, voffB); PG8_STAGE(PG8_SA(0, 0), a2, voffA);
            PG8_WAIT_V(8); PG8_WAIT_L(0); PG8_BAR; PG8_MMA(1, 0, At, B0); PG8_MMA(1, 1, At, B1); PG8_BAR; PG8_SCHED;
            PG8_LDB(B0, 1, 0); PG8_LDB(B1, 1, 1); PG8_SCHED; PG8_LDA(At, 1, 0); PG8_STAGE(PG8_SA(0, 1), a2 + hstep, voffA);
            PG8_WAIT_V(8); PG8_WAIT_L(0); PG8_BAR; PG8_MMA(0, 0, At, B0); PG8_MMA(0, 1, At, B1); PG8_BAR; PG8_SCHED;
            PG8_LDA(At, 1, 1); PG8_STAGE(PG8_SB(1, 0), b3, voffB); PG8_STAGE(PG8_SB(1, 1), b3 + hstep, voffB); PG8_STAGE(PG8_SA(1, 0), a3, voffA);
            PG8_WAIT_V(8); PG8_WAIT_L(0); PG8_BAR; PG8_MMA(1, 0, At, B0); PG8_MMA(1, 1, At, B1); PG8_BAR; PG8_SCHED;
        }
        if (wr == 0) PG8_BAR;
        E(acc, cur.pm, cur.pn, cur.z, wr, wc, fr, fq);
        if (!has_next) break;
#pragma unroll
        for (int a = 0; a < 2; ++a)
#pragma unroll
            for (int b = 0; b < 2; ++b)
#pragma unroll
                for (int m = 0; m < 4; ++m)
#pragma unroll
                    for (int n = 0; n < 2; ++n) acc[a][b][m][n] = (f32x4){0.f, 0.f, 0.f, 0.f};
        cur = nxt; cA = nA; cB = nB; ++ui;
        if (wr == 1) PG8_BAR;
    }
    PG8_WAIT_V(0);
    PG8_BAR;
#undef PG8_SA
#undef PG8_SB
#undef PG8_STAGE
#undef PG8_LDA
#undef PG8_LDB
#undef PG8_MMA
#undef PG8_WAIT_V
#undef PG8_WAIT_L
#undef PG8_BAR
#undef PG8_SCHED
}
}

struct EpiIn {
    bf16_t *QF, *QS, *KF, *VF, *KS, *VS, *GF, *GS; const float* rope;
    __device__ __forceinline__ void operator()(const f32x4 (&acc)[2][2][4][2], int pm, int pn, int z, int wr, int wc, int fr, int fq) const {
#pragma unroll
        for (int bj = 0; bj < 2; ++bj) {
            bf16_t* base; int ld, col, mode;
            if (pn < 2) { base = QF; ld = 512; col = pn * 256 + bj * 128; mode = 1; }
            else if (pn < 4) { base = QS; ld = 512; col = (pn - 2) * 256 + bj * 128; mode = 2; }
            else if (pn < 6) { base = KF; ld = 512; col = (pn - 4) * 256 + bj * 128; mode = 0; }
            else if (pn < 8) { base = VF; ld = 512; col = (pn - 6) * 256 + bj * 128; mode = 0; }
            else if (pn == 8) { if (bj == 0) { base = KS; mode = 3; } else { base = VS; mode = 0; } ld = 128; col = 0; }
            else if (pn < 13) { base = GF; ld = 1024; col = (pn - 9) * 256 + bj * 128; mode = 4; }
            else { base = GS; ld = 1024; col = (pn - 13) * 256 + bj * 128; mode = 4; }
            char* tb = (char*)(base + (size_t)(pm * 256) * ld + col);
            const unsigned lo = (unsigned)((wr * 64 + fr) * ld + wc * 32 + 8 * fq) * 2u;
            const int j0 = 16 * (wc & 1) + 4 * fq;
            const int pos0 = ((pm * 256) & (SEQ - 1)) + wr * 64 + fr;
#pragma unroll
            for (int ai = 0; ai < 2; ++ai)
#pragma unroll
                for (int m = 0; m < 4; ++m) {
                    f32x4 v0 = acc[ai][bj][m][0], v1 = acc[ai][bj][m][1];
                    if (mode == 2 || mode == 3) {
                        const int pos = pos0 + ai * 128 + m * 16;
                        const f32x4 t0 = *(const f32x4*)(rope + (size_t)(pos * 32 + j0) * 2), t1 = *(const f32x4*)(rope + (size_t)(pos * 32 + j0 + 2) * 2);
                        f32x4 r0, r1;
                        r0[0] = v0[0] * t0[0] - v0[1] * t0[1]; r0[1] = v0[1] * t0[0] + v0[0] * t0[1];
                        r0[2] = v0[2] * t0[2] - v0[3] * t0[3]; r0[3] = v0[3] * t0[2] + v0[2] * t0[3];
                        r1[0] = v1[0] * t1[0] - v1[1] * t1[1]; r1[1] = v1[1] * t1[0] + v1[0] * t1[1];
                        r1[2] = v1[2] * t1[2] - v1[3] * t1[3]; r1[3] = v1[3] * t1[2] + v1[2] * t1[3];
                        v0 = r0; v1 = r1;
                    }
                    if (mode == 1 || mode == 2) { v0 = v0 * C2; v1 = v1 * C2; }
                    if (mode == 4) {
#pragma unroll
                        for (int i = 0; i < 4; ++i) { v0[i] = sigmoidf_(v0[i]); v1[i] = sigmoidf_(v1[i]); }
                    }
                    *(u32x4*)(tb + (size_t)((ai * 128 + m * 16) * ld * 2) + lo) = pk8(v0, v1);
                }
        }
    }
};
struct EpiGate {
    const bf16_t *GF, *GS; bf16_t* MG;
    __device__ __forceinline__ void operator()(const f32x4 (&acc)[2][2][4][2], int pm, int pn, int z, int wr, int wc, int fr, int fq) const {
        const size_t tile = (size_t)(pm * 256) * 1024 + pn * 256;
        const char* gb = (const char*)((z ? GS : GF) + tile); char* mb = (char*)(MG + tile);
        const unsigned lo = (unsigned)((wr * 64 + fr) * 1024 + wc * 32 + 8 * fq) * 2u;
#pragma unroll
        for (int ai = 0; ai < 2; ++ai)
#pragma unroll
            for (int m = 0; m < 4; ++m)
#pragma unroll
                for (int bj = 0; bj < 2; ++bj) {
                    const size_t d = (size_t)((ai * 128 + m * 16) * 1024 + bj * 128) * 2;
                    f32x4 g0, g1; unpk8(*(const u32x4*)(gb + d + lo), g0, g1);
                    f32x4 v0 = acc[ai][bj][m][0] * g0, v1 = acc[ai][bj][m][1] * g1;
                    if (z) { f32x4 p0, p1; unpk8(*(const u32x4*)(mb + d + lo), p0, p1); v0 += p0; v1 += p1; }
                    *(u32x4*)(mb + d + lo) = pk8(v0, v1);
                    if (bj) asm volatile("" ::: "memory");
                }
    }
};
struct EpiRes {
    const float* R; float* Y;
    __device__ __forceinline__ void operator()(const f32x4 (&acc)[2][2][4][2], int pm, int pn, int z, int wr, int wc, int fr, int fq) const {
        const size_t tile = (size_t)(pm * 256) * 1024 + pn * 256;
        const char* rb = (const char*)(R + tile); char* yb = (char*)(Y + tile);
        const unsigned lo = (unsigned)((wr * 64 + fr) * 1024 + wc * 32 + 8 * fq) * 4u;
#pragma unroll
        for (int ai = 0; ai < 2; ++ai)
#pragma unroll
            for (int m = 0; m < 4; ++m)
#pragma unroll
                for (int bj = 0; bj < 2; ++bj) {
                    const size_t d = (size_t)((ai * 128 + m * 16) * 1024 + bj * 128) * 4;
                    const f32x4 r0 = *(const f32x4*)(rb + d + lo), r1 = *(const f32x4*)(rb + d + lo + 16);
                    *(f32x4*)(yb + d + lo) = r0 * ALPHA + acc[ai][bj][m][0]; *(f32x4*)(yb + d + lo + 16) = r1 * ALPHA + acc[ai][bj][m][1];
                    if (bj) asm volatile("" ::: "memory");
                }
    }
};
struct EpiSwiglu {
    bf16_t* HM;
    __device__ __forceinline__ void operator()(const f32x4 (&acc)[2][2][4][2], int pm, int pn, int z, int wr, int wc, int fr, int fq) const {
        char* hb = (char*)(HM + (size_t)(pm * 256) * DFF + pn * 128);
        const unsigned lo = (unsigned)((wr * 64 + fr) * DFF + wc * 32 + 8 * fq) * 2u;
#pragma unroll
        for (int ai = 0; ai < 2; ++ai)
#pragma unroll
            for (int m = 0; m < 4; ++m) {
                f32x4 h0, h1;
#pragma unroll
                for (int i = 0; i < 4; ++i) { const float g0 = acc[ai][0][m][0][i], g1 = acc[ai][0][m][1][i];
                    h0[i] = g0 * sigmoidf_(g0) * acc[ai][1][m][0][i]; h1[i] = g1 * sigmoidf_(g1) * acc[ai][1][m][1][i]; }
                *(u32x4*)(hb + (size_t)((ai * 128 + m * 16) * DFF * 2) + lo) = pk8(h0, h1);
            }
    }
};

__device__ __forceinline__ void ln_rows(float* Y, const float* gam, const float* bet, bf16_t* HB, int gw, int ngw, int lane) {
    f32x4 gv[4], bv[4];
#pragma unroll
    for (int j = 0; j < 4; ++j) { gv[j] = *((const f32x4*)gam + lane + 64 * j); bv[j] = *((const f32x4*)bet + lane + 64 * j); }
    for (int m = gw; m < M; m += ngw) {
        f32x4* yr = (f32x4*)(Y + (size_t)m * DM) + lane;
        f32x4 v[4]; float s = 0.f;
#pragma unroll
        for (int j = 0; j < 4; ++j) { v[j] = yr[64 * j]; s += (v[j][0] + v[j][1]) + (v[j][2] + v[j][3]); }
        const float mean = wave_sum(s) * (1.f / DM); float s2 = 0.f;
#pragma unroll
        for (int j = 0; j < 4; ++j) { v[j] = v[j] - mean; s2 += (v[j][0] * v[j][0] + v[j][1] * v[j][1]) + (v[j][2] * v[j][2] + v[j][3] * v[j][3]); }
        const float rstd = 1.f / sqrtf(wave_sum(s2) * (1.f / DM) + LN_EPS);
#pragma unroll
        for (int j = 0; j < 4; ++j) {
            const f32x4 o = v[j] * rstd * gv[j] + bv[j];
            yr[64 * j] = o;
            if (HB) { u32x2 w; w.x = pk_bf16(o[0], o[1]); w.y = pk_bf16(o[2], o[3]); *((u32x2*)(HB + (size_t)m * DM) + lane + 64 * j) = w; }
        }
    }
}

template <int MODE> __device__ __forceinline__ void attn_simple(bf16_t* Q, const bf16_t* K, const bf16_t* V, const float* CL, const float* sinks, int gw, int ngw, int lane) {
    constexpr int KLD = MODE == 0 ? 512 : 128;
    for (int i = 0;; ++i) {
        const int u = gw + i * ngw; if (u >= 8192) break;
        const int bh = u >> 5; int qk = u & 31; if (i & 1) qk = 31 - qk;
        const int b = bh >> 3, h = bh & 7, kh = MODE == 0 ? h : (h >> 2);
        const int q = qk * 64 + lane;
        bf16_t* qp = Q + (size_t)(b * SEQ + q) * 512 + h * 64;
        float qv[64], o[64];
#pragma unroll
        for (int c = 0; c < 8; ++c) { const u32x4 w = *((const u32x4*)qp + c);
            qv[8 * c + 0] = bf_lo(w.x); qv[8 * c + 1] = bf_hi(w.x); qv[8 * c + 2] = bf_lo(w.y); qv[8 * c + 3] = bf_hi(w.y);
            qv[8 * c + 4] = bf_lo(w.z); qv[8 * c + 5] = bf_hi(w.z); qv[8 * c + 6] = bf_lo(w.w); qv[8 * c + 7] = bf_hi(w.w); }
#pragma unroll
        for (int d = 0; d < 64; ++d) o[d] = 0.f;
        float mx, l, cli = 0.f;
        if (MODE == 0) { mx = -INFINITY; l = 0.f; cli = CL[bh * SEQ + q]; } else { mx = sinks[h] * LOG2E; l = 1.f; }
        const int jlo = MODE == 0 ? 0 : (qk * 64 - 127 > 0 ? qk * 64 - 127 : 0), jhi = qk * 64 + 63;
        const bf16_t* kb = K + (size_t)(b * SEQ) * KLD + kh * 64;
        const bf16_t* vb = V + (size_t)(b * SEQ) * KLD + kh * 64;
        for (int j = jlo; j <= jhi; ++j) {
            const u32x4* kr = (const u32x4*)(kb + (size_t)j * KLD);
            float s = 0.f;
#pragma unroll
            for (int c = 0; c < 8; ++c) { const u32x4 w = kr[c];
                s += qv[8 * c + 0] * bf_lo(w.x) + qv[8 * c + 1] * bf_hi(w.x) + qv[8 * c + 2] * bf_lo(w.y) + qv[8 * c + 3] * bf_hi(w.y)
                   + qv[8 * c + 4] * bf_lo(w.z) + qv[8 * c + 5] * bf_hi(w.z) + qv[8 * c + 6] * bf_lo(w.w) + qv[8 * c + 7] * bf_hi(w.w); }
            bool act;
            if (MODE == 0) { s += cli - CL[bh * SEQ + j]; act = j <= q; } else { act = (j <= q) && (q - j < 128); }
            if (act) {
                const float mn = fmaxf(mx, s), sc = exp2f(mx - mn), p = exp2f(s - mn);
                mx = mn; l = l * sc + p;
                const u32x4* vr = (const u32x4*)(vb + (size_t)j * KLD);
#pragma unroll
                for (int c = 0; c < 8; ++c) { const u32x4 w = vr[c];
                    o[8 * c + 0] = o[8 * c + 0] * sc + p * bf_lo(w.x); o[8 * c + 1] = o[8 * c + 1] * sc + p * bf_hi(w.x);
                    o[8 * c + 2] = o[8 * c + 2] * sc + p * bf_lo(w.y); o[8 * c + 3] = o[8 * c + 3] * sc + p * bf_hi(w.y);
                    o[8 * c + 4] = o[8 * c + 4] * sc + p * bf_lo(w.z); o[8 * c + 5] = o[8 * c + 5] * sc + p * bf_hi(w.z);
                    o[8 * c + 6] = o[8 * c + 6] * sc + p * bf_lo(w.w); o[8 * c + 7] = o[8 * c + 7] * sc + p * bf_hi(w.w); }
            }
        }
        const float rl = 1.f / l;
#pragma unroll
        for (int c = 0; c < 8; ++c) { u32x4 w;
            w.x = pk_bf16(o[8 * c + 0] * rl, o[8 * c + 1] * rl); w.y = pk_bf16(o[8 * c + 2] * rl, o[8 * c + 3] * rl);
            w.z = pk_bf16(o[8 * c + 4] * rl, o[8 * c + 5] * rl); w.w = pk_bf16(o[8 * c + 6] * rl, o[8 * c + 7] * rl);
            *((u32x4*)qp + c) = w; }
    }
}

struct Params { const float* in[14]; float* out; unsigned char* ws; };

__global__ void __launch_bounds__(NTHREADS, 2) fwd_kernel(Params p) {
    extern __shared__ __attribute__((aligned(16))) unsigned char lds[];
    cg::grid_group grid = cg::this_grid();
    const int tid = threadIdx.x, lane = tid & 63, wid = __builtin_amdgcn_readfirstlane(tid >> 6);
    const int gw = blockIdx.x * NWAVES + wid, ngw = gridDim.x * NWAVES;
    const int gtid = blockIdx.x * NTHREADS + tid, ngt = gridDim.x * NTHREADS;
    unsigned char* ws = p.ws;
#ifdef SIMPLE_GEMM
#define RUN_GEMM(g, E) gemm_simple(g, E)
#else
#define RUN_GEMM(g, E) do { pg8::Order S_; S_.init((g).nM, (g).nN, (g).nZ, (int)gridDim.x, (int)blockIdx.x); pg8::gemm_phase((PG8_LAS unsigned char*)lds, g, S_, E); } while (0)
#endif
    const float *x = p.in[0], *w_in = p.in[1], *b_forget = p.in[2], *sinks = p.in[3], *w_o_fox = p.in[4], *w_o_swa = p.in[5], *w_out = p.in[6],
                *ln1_g = p.in[7], *ln1_b = p.in[8], *w_gate = p.in[9], *w_up = p.in[10], *w_down = p.in[11], *ln2_g = p.in[12], *ln2_b = p.in[13];
    float* rope = (float*)(ws + WS_ROPE); float* logf_ = (float*)(ws + WS_LOGF); float* CL = (float*)(ws + WS_CL);
    bf16_t *WIN = (bf16_t*)(ws + WS_WIN), *WOF = (bf16_t*)(ws + WS_WOF), *WOS = (bf16_t*)(ws + WS_WOS), *WOUT = (bf16_t*)(ws + WS_WOUT), *WGU = (bf16_t*)(ws + WS_WGU), *WD = (bf16_t*)(ws + WS_WD);
    bf16_t *XB = (bf16_t*)(ws + WS_XB), *QF = (bf16_t*)(ws + WS_QF), *QS = (bf16_t*)(ws + WS_QS), *KF = (bf16_t*)(ws + WS_KF), *VF = (bf16_t*)(ws + WS_VF),
           *KS = (bf16_t*)(ws + WS_KS), *VS = (bf16_t*)(ws + WS_VS), *GF = (bf16_t*)(ws + WS_GF), *GS = (bf16_t*)(ws + WS_GS), *HM = (bf16_t*)(ws + WS_HM);

    conv_w(DM, NPROJ, INCOLS, WIN, ColIn{w_in}, gtid, ngt);
    conv_w(512, DM, DM, WOF, ColId{w_o_fox}, gtid, ngt);
    conv_w(512, DM, DM, WOS, ColId{w_o_swa}, gtid, ngt);
    conv_w(DM, DM, DM, WOUT, ColId{w_out}, gtid, ngt);
    conv_w(DM, NGU, DFF, WGU, ColGU{w_gate, w_up}, gtid, ngt);
    conv_w(DFF, DM, DM, WD, ColId{w_down}, gtid, ngt);
    for (int it = gtid; it < SEQ * 32; it += ngt) {
        const int pos = it >> 5, j = it & 31;
        const float inv_freq = exp2f(-(float)j * (13.287712379549449f / 32.f));
        const float ang = (float)pos * inv_freq;
        float c, s; sincos_acc(ang, c, s);
        rope[2 * it] = c; rope[2 * it + 1] = s;
    }
#ifndef NO_P0
    {
        f32x4 wf[4][4][2];
#pragma unroll
        for (int j = 0; j < 4; ++j)
#pragma unroll
            for (int e = 0; e < 4; ++e) { const float* wp = w_in + (size_t)(256 * j + 4 * lane + e) * INCOLS + 1536; wf[j][e][0] = *(const f32x4*)wp; wf[j][e][1] = *(const f32x4*)(wp + 4); }
        const float bfv = b_forget[lane & 7];
        for (int m = gw; m < M; m += ngw) {
            const f32x4* xr = (const f32x4*)(x + (size_t)m * DM) + lane;
            f32x4 a0 = {0.f, 0.f, 0.f, 0.f}, a1 = {0.f, 0.f, 0.f, 0.f};
#pragma unroll
            for (int j = 0; j < 4; ++j) { const f32x4 v = xr[64 * j];
                u32x2 w; w.x = pk_bf16(v[0], v[1]); w.y = pk_bf16(v[2], v[3]); *((u32x2*)(XB + (size_t)m * DM) + lane + 64 * j) = w;
#pragma unroll
                for (int e = 0; e < 4; ++e) { a0 += wf[j][e][0] * v[e]; a1 += wf[j][e][1] * v[e]; } }
            float r[8] = {a0[0], a0[1], a0[2], a0[3], a1[0], a1[1], a1[2], a1[3]};
#pragma unroll
            for (int hh = 0; hh < 8; ++hh) r[hh] = wave_sum(r[hh]);
            float mine = r[0];
#pragma unroll
            for (int hh = 1; hh < 8; ++hh) mine = (lane & 7) == hh ? r[hh] : mine;
            if (lane < 8) { const float zz = mine + bfv; logf_[(size_t)m * 8 + lane] = fminf(zz, 0.f) - log1pf(__expf(-fabsf(zz))); }
        }
    }
#endif
    grid.sync();

    {
        double* sc = (double*)lds;
        for (int seq = blockIdx.x; seq < BATCH * 8; seq += gridDim.x) {
            const int b = seq >> 3, h = seq & 7;
            double v[4]; double s = 0.0;
#pragma unroll
            for (int e = 0; e < 4; ++e) { v[e] = (double)logf_[(size_t)(b * SEQ + tid * 4 + e) * 8 + h]; s += v[e]; }
            __syncthreads();
            sc[tid] = s;
            __syncthreads();
            double pre = 0.0;
            for (int i = 0; i < tid; ++i) pre += sc[i];
#pragma unroll
            for (int e = 0; e < 4; ++e) { pre += v[e]; CL[(size_t)seq * SEQ + tid * 4 + e] = (float)(pre * 1.4426950408889634); }
        }
        __syncthreads();
        Gemm g{XB, XB, WIN, WIN, DM, DM, DM, M / 256, NPROJ / 256, 1};
#ifndef NO_P1
        RUN_GEMM(g, (EpiIn{QF, QS, KF, VF, KS, VS, GF, GS, rope}));
#endif
    }
    grid.sync();

#ifndef NO_ATT
    attn_simple<0>(QF, KF, VF, CL, sinks, gw, ngw, lane);
    attn_simple<1>(QS, KS, VS, CL, sinks, gw, ngw, lane);
#endif
    grid.sync();

    { Gemm g{QF, QS, WOF, WOS, 512, 512, 512, M / 256, DM / 256, 2}; RUN_GEMM(g, (EpiGate{GF, GS, XB})); }
    grid.sync();

    { Gemm g{XB, XB, WOUT, WOUT, DM, DM, DM, M / 256, DM / 256, 1}; RUN_GEMM(g, (EpiRes{x, p.out})); }
    grid.sync();
    ln_rows(p.out, ln1_g, ln1_b, XB, gw, ngw, lane);
    grid.sync();

    { Gemm g{XB, XB, WGU, WGU, DM, DM, DM, M / 256, NGU / 256, 1}; RUN_GEMM(g, (EpiSwiglu{HM})); }
    grid.sync();

    { Gemm g{HM, HM, WD, WD, DFF, DFF, DFF, M / 256, DM / 256, 1}; RUN_GEMM(g, (EpiRes{p.out, p.out})); }
    grid.sync();
    ln_rows(p.out, ln2_g, ln2_b, nullptr, gw, ngw, lane);
}

extern "C" void kernel_launch(void* const* d_in, const int* in_sizes, int n_in, void* d_out, int out_size, void* d_ws, size_t ws_size, hipStream_t stream) {
    static int grid_blocks = 0;
    if (grid_blocks == 0) {
        if (n_in != 14 || out_size != M * DM || ws_size < WS_END) { fprintf(stderr, "kernel_launch: unexpected shapes (n_in %d out %d ws %zu)\n", n_in, out_size, ws_size); grid_blocks = -1; return; }
        int dev = 0, cus = 0, per_cu = 0;
        hipGetDevice(&dev);
        hipDeviceGetAttribute(&cus, hipDeviceAttributeMultiprocessorCount, dev);
        hipFuncSetAttribute((const void*)fwd_kernel, hipFuncAttributeMaxDynamicSharedMemorySize, LDS_BYTES);
        hipOccupancyMaxActiveBlocksPerMultiprocessor(&per_cu, (const void*)fwd_kernel, NTHREADS, LDS_BYTES);
        if (per_cu < 1) { fprintf(stderr, "kernel_launch: occupancy query says %d blocks per CU\n", per_cu); per_cu = 1; }
        (void)hipGetLastError();
        grid_blocks = cus * 1;
    }
    if (grid_blocks < 0) return;
    Params p{};
    for (int i = 0; i < 14; ++i) p.in[i] = (const float*)d_in[i];
    p.out = (float*)d_out; p.ws = (unsigned char*)d_ws;
    void* args[] = {&p};
    hipError_t e = hipLaunchCooperativeKernel((const void*)fwd_kernel, dim3(grid_blocks), dim3(NTHREADS), args, LDS_BYTES, stream);
    if (e != hipSuccess) fprintf(stderr, "cooperative launch failed: %s (grid %d)\n", hipGetErrorString(e), grid_blocks);
}
```

```cpp
#include <hip/hip_runtime.h>
#include <hip/hip_cooperative_groups.h>
#include <cstdio>
#include <cstdint>
namespace cg = cooperative_groups;

typedef unsigned short bf16_t;
typedef short bf16x8 __attribute__((ext_vector_type(8)));
typedef float f32x4 __attribute__((ext_vector_type(4)));
typedef float f32x2 __attribute__((ext_vector_type(2)));
typedef unsigned u32x4 __attribute__((ext_vector_type(4)));
typedef unsigned u32x2 __attribute__((ext_vector_type(2)));
typedef __bf16 bf16x2_t __attribute__((ext_vector_type(2)));

constexpr int BATCH = 32, SEQ = 2048, DM = 1024, M = BATCH * SEQ;
constexpr int NPROJ = 4352;
constexpr int INCOLS = 4360;
constexpr int DFF = 2816, NGU = 2 * DFF;
constexpr int NTHREADS = 512, NWAVES = 8;
constexpr float LOG2E = 1.4426950408889634f;
constexpr float C2 = 0.125f * LOG2E;
constexpr float ALPHA = 1.189207115002721f;
constexpr float LN_EPS = 1e-5f;
constexpr int LDS_BYTES = 147456;

constexpr size_t MiB = 1u << 20;
constexpr size_t WS_ROPE = 1 * MiB;
constexpr size_t WS_LOGF = 2 * MiB;
constexpr size_t WS_CL = 4 * MiB;
constexpr size_t WS_WIN = 8 * MiB;
constexpr size_t WS_WOF = 17 * MiB;
constexpr size_t WS_WOS = 18 * MiB;
constexpr size_t WS_WOUT = 19 * MiB;
constexpr size_t WS_WGU = 21 * MiB;
constexpr size_t WS_WD = 32 * MiB;
constexpr size_t WS_XB = 40 * MiB;
constexpr size_t WS_QF = 168 * MiB;
constexpr size_t WS_QS = 232 * MiB;
constexpr size_t WS_KF = 296 * MiB;
constexpr size_t WS_VF = 360 * MiB;
constexpr size_t WS_KS = 424 * MiB;
constexpr size_t WS_VS = 440 * MiB;
constexpr size_t WS_GF = 456 * MiB;
constexpr size_t WS_GS = 584 * MiB;
constexpr size_t WS_HM = 168 * MiB;
constexpr size_t WS_END = 712 * MiB;

__device__ __forceinline__ unsigned pk_bf16(float lo, float hi) { f32x2 v = {lo, hi}; bf16x2_t b = __builtin_convertvector(v, bf16x2_t); return __builtin_bit_cast(unsigned, b); }
__device__ __forceinline__ float bf_lo(unsigned w) { return __uint_as_float(w << 16); }
__device__ __forceinline__ float bf_hi(unsigned w) { return __uint_as_float(w & 0xffff0000u); }
__device__ __forceinline__ u32x4 pk8(f32x4 a, f32x4 b) { u32x4 w; w.x = pk_bf16(a[0], a[1]); w.y = pk_bf16(a[2], a[3]); w.z = pk_bf16(b[0], b[1]); w.w = pk_bf16(b[2], b[3]); return w; }
__device__ __forceinline__ void unpk8(u32x4 w, f32x4& a, f32x4& b) { a = (f32x4){bf_lo(w.x), bf_hi(w.x), bf_lo(w.y), bf_hi(w.y)}; b = (f32x4){bf_lo(w.z), bf_hi(w.z), bf_lo(w.w), bf_hi(w.w)}; }
__device__ __forceinline__ float wave_sum(float v) {
#pragma unroll
    for (int o = 1; o < 64; o <<= 1) v += __shfl_xor(v, o);
    return v;
}
__device__ __forceinline__ float sigmoidf_(float g) { return __builtin_amdgcn_rcpf(1.0f + __expf(-g)); }

__device__ __forceinline__ void sincos_acc(float a, float& c, float& s) {
    const double x = (double)a;
    const double k = __builtin_rint(x * 0.63661977236758134308);
    double r = __builtin_fma(-k, 1.57079632679489655800, x); r = __builtin_fma(-k, 6.12323399573676603587e-17, r);
    const int q = ((int)k) & 3;
    const double r2 = r * r;
    const double sn = r * (1.0 + r2 * (-1.0 / 6 + r2 * (1.0 / 120 + r2 * (-1.0 / 5040 + r2 * (1.0 / 362880 + r2 * (-1.0 / 39916800 + r2 * (1.0 / 6227020800.0)))))));
    const double cs = 1.0 + r2 * (-0.5 + r2 * (1.0 / 24 + r2 * (-1.0 / 720 + r2 * (1.0 / 40320 + r2 * (-1.0 / 3628800 + r2 * (1.0 / 479001600.0))))));
    double ss, cc;
    if (q == 0) { ss = sn; cc = cs; } else if (q == 1) { ss = cs; cc = -sn; } else if (q == 2) { ss = -sn; cc = -cs; } else { ss = -cs; cc = sn; }
    c = (float)cc; s = (float)ss;
}

template <class F> __device__ __forceinline__ void conv_w(int K, int N, int ldw, bf16_t* WT, const F& col, int gtid, int ngt) {
    const int nkb = K / 8; const int items = N * nkb;
    for (int it = gtid; it < items; it += ngt) {
        const int nb = it / (64 * nkb), rem = it - nb * (64 * nkb), kb = rem >> 6, n = nb * 64 + (rem & 63), k0 = kb * 8;
        const float* c = col(n) + (size_t)k0 * ldw;
        float v[8];
#pragma unroll
        for (int i = 0; i < 8; ++i) v[i] = c[(size_t)i * ldw];
        u32x4 w; w.x = pk_bf16(v[0], v[1]); w.y = pk_bf16(v[2], v[3]); w.z = pk_bf16(v[4], v[5]); w.w = pk_bf16(v[6], v[7]);
        *(u32x4*)(WT + (size_t)n * K + k0) = w;
    }
}
struct ColIn { const float* W;
    __device__ __forceinline__ const float* operator()(int n) const {
        int s;
        if (n < 512) s = n;
        else if (n < 1024) { const int r = n - 512, hh = r >> 6, p = r & 63; s = 1544 + hh * 64 + (p >> 1) + 32 * (p & 1); }
        else if (n < 1536) s = 512 + (n - 1024);
        else if (n < 2048) s = 1024 + (n - 1536);
        else if (n < 2176) { const int r = n - 2048, hh = r >> 6, p = r & 63; s = 2056 + hh * 64 + (p >> 1) + 32 * (p & 1); }
        else if (n < 2304) s = 2184 + (n - 2176);
        else if (n < 3328) s = 2312 + (n - 2304);
        else s = 3336 + (n - 3328);
        return W + s; } };
struct ColId { const float* W; __device__ __forceinline__ const float* operator()(int n) const { return W + n; } };
struct ColGU { const float* Wg; const float* Wu; __device__ __forceinline__ const float* operator()(int n) const { const int t = n >> 8, r = n & 255; return r < 128 ? Wg + 128 * t + r : Wu + 128 * t + (r - 128); } };

struct Gemm { const bf16_t *A0, *A1, *B0, *B1; int lda, ldb, K, nM, nN, nZ; };

template <class Epi> __device__ __forceinline__ void gemm_simple(const Gemm g, const Epi& E) {
    const int tid = threadIdx.x, wid = __builtin_amdgcn_readfirstlane(tid >> 6), lane = tid & 63, wr = wid >> 2, wc = wid & 3, fr = lane & 15, fq = lane >> 4;
    const int nunits = g.nM * g.nN;
    for (int u = blockIdx.x; u < nunits; u += gridDim.x) {
        const int pn = u % g.nN, pm = u / g.nN;
        for (int z = 0; z < g.nZ; ++z) {
            f32x4 acc[2][2][4][2];
#pragma unroll
            for (int a = 0; a < 2; ++a)
#pragma unroll
                for (int b = 0; b < 2; ++b)
#pragma unroll
                    for (int m = 0; m < 4; ++m)
#pragma unroll
                        for (int n = 0; n < 2; ++n) acc[a][b][m][n] = (f32x4){0.f, 0.f, 0.f, 0.f};
            const char* Abase = (const char*)((z ? g.A1 : g.A0) + (size_t)(pm * 256) * g.lda);
            const char* Bbase = (const char*)((z ? g.B1 : g.B0) + (size_t)(pn * 256) * g.ldb);
            const unsigned offA = (unsigned)((wr * 64 + fr) * g.lda + fq * 8) * 2u;
            const unsigned offB = (unsigned)((wc * 32 + 8 * (fr >> 2) + (fr & 3)) * g.ldb + fq * 8) * 2u;
#pragma unroll 1
            for (int kt = 0; kt < g.K; kt += 64) {
#pragma unroll
                for (int bj = 0; bj < 2; ++bj) {
                    bf16x8 Bf[2][2];
#pragma unroll
                    for (int n = 0; n < 2; ++n) { const char* rp = Bbase + (size_t)(bj * 128 + 4 * n) * g.ldb * 2 + kt * 2;
#pragma unroll
                        for (int k = 0; k < 2; ++k) Bf[n][k] = *(const bf16x8*)(rp + offB + 64 * k); }
#pragma unroll
                    for (int ai = 0; ai < 2; ++ai)
#pragma unroll
                        for (int m = 0; m < 4; ++m) {
                            bf16x8 Af[2]; const char* rp = Abase + (size_t)(ai * 128 + m * 16) * g.lda * 2 + kt * 2;
#pragma unroll
                            for (int k = 0; k < 2; ++k) Af[k] = *(const bf16x8*)(rp + offA + 64 * k);
#pragma unroll
                            for (int n = 0; n < 2; ++n)
#pragma unroll
                                for (int k = 0; k < 2; ++k) acc[ai][bj][m][n] = __builtin_amdgcn_mfma_f32_16x16x32_bf16(Bf[n][k], Af[k], acc[ai][bj][m][n], 0, 0, 0);
                        }
                }
            }
            E(acc, pm, pn, z, wr, wc, fr, fq);
        }
    }
}

#define PG8_LAS __attribute__((address_space(3)))
namespace pg8 {
constexpr int BM = 256, BK = 64, HALF = 128, HTB = HALF * BK * 2, STAGE_BYTES = 8 * HTB, NXCD = 8, WGM = 8;
__device__ __forceinline__ int lds_byte(int r, int c) { const int st = (r >> 4) * 2 + (c >> 5), rr = r & 15, cc = c & 31, ob = rr * 64 + cc * 2; return st * 1024 + (ob ^ (((ob >> 9) & 1) << 5)); }
__device__ __forceinline__ void stage_rc(int b, int& R, int& C) { const int st = b / 1024, sb = b % 1024, swz = sb ^ (((sb >> 9) & 1) << 5); R = (st >> 1) * 16 + swz / 64; C = (st & 1) * 32 + (swz % 64) / 2; }
__device__ __forceinline__ int perm32(int rho) { const int n = rho >> 4, i = rho & 15; return 8 * (i >> 2) + 4 * n + (i & 3); }
struct Unit { int pm, pn, z; };
struct Order {
    int nM, nN, nwg, G, c, nZ;
    __device__ __forceinline__ void init(int nM_, int nN_, int nZ_, int G_, int c_) { nM = nM_; nN = nN_; nwg = nM * nN; G = G_; c = c_; nZ = nZ_; }
    __device__ __forceinline__ bool next(int i, Unit& u) const {
        const int ti = i / nZ; u.z = i - ti * nZ;
        const long L = (long)ti * G + c; if (L >= nwg) return false;
        int wgid = (int)L; { const int q = nwg / NXCD, r = nwg % NXCD, xcd = wgid % NXCD, off = wgid / NXCD; wgid = (xcd < r ? xcd * (q + 1) : r * (q + 1) + (xcd - r) * q) + off; }
        const int nig = WGM * nN, gid = wgid / nig, fm = gid * WGM, gsz = (nM - fm) < WGM ? (nM - fm) : WGM;
        u.pm = fm + ((wgid % nig) % gsz); u.pn = (wgid % nig) / gsz; return true;
    }
};
template <class Epi>
__device__ __forceinline__ void gemm_phase(PG8_LAS unsigned char* lds, const Gemm g, const Order& S, const Epi& E) {
    int tid = threadIdx.x; asm volatile("" : "+v"(tid));
    const int wid = __builtin_amdgcn_readfirstlane(tid >> 6), lane = tid & 63, wr = wid >> 2, wc = wid & 3, fr = lane & 15, fq = lane >> 4;
    const int K = g.K, nt = K / BK;
    unsigned voffA[2], voffB[2];
#pragma unroll
    for (int i = 0; i < 2; ++i) { int R, C; stage_rc(tid * 16 + i * 8192, R, C); const int Rb = (R & ~31) + perm32(R & 31);
        voffA[i] = (unsigned)(R * K + C) * 2u; voffB[i] = (unsigned)(Rb * K + C) * 2u; }
    const size_t kstep = (size_t)(BK * 2);
    const size_t hstep = (size_t)HALF * K * 2;
    const size_t tstep = 2 * hstep;
    const unsigned ldsw = (unsigned)wid * 1024u;
    const int aoff = lds_byte(wr * 64 + fr, fq * 8), boff = lds_byte(wc * 32 + fr, fq * 8);
#define PG8_SA(b, h) (((b) * 2 + (h)) * HTB)
#define PG8_SB(b, h) ((4 + (b) * 2 + (h)) * HTB)
#define PG8_STAGE(bufoff, gbase, voff) do { _Pragma("unroll") for (int _i = 0; _i < 2; ++_i) \
        __builtin_amdgcn_global_load_lds((const unsigned*)((const char*)(gbase) + (voff)[_i]), (PG8_LAS unsigned*)(lds + (bufoff) + ldsw + _i * 8192), 16, 0, 0); } while (0)
#define PG8_LDA(dst, b, h) do { _Pragma("unroll") for (int m = 0; m < 4; ++m) _Pragma("unroll") for (int k = 0; k < 2; ++k) dst[m][k] = *(const PG8_LAS bf16x8*)(lds + PG8_SA(b, h) + aoff + m * 2048 + k * 1024); } while (0)
#define PG8_LDB(dst, b, h) do { _Pragma("unroll") for (int n = 0; n < 2; ++n) _Pragma("unroll") for (int k = 0; k < 2; ++k) dst[n][k] = *(const PG8_LAS bf16x8*)(lds + PG8_SB(b, h) + boff + n * 2048 + k * 1024); } while (0)
#define PG8_MMA(ai, bj, At, Bt) do { __builtin_amdgcn_s_setprio(1); _Pragma("unroll") for (int m = 0; m < 4; ++m) _Pragma("unroll") for (int n = 0; n < 2; ++n) _Pragma("unroll") for (int k = 0; k < 2; ++k) \
        acc[ai][bj][m][n] = __builtin_amdgcn_mfma_f32_16x16x32_bf16(Bt[n][k], At[m][k], acc[ai][bj][m][n], 0, 0, 0); __builtin_amdgcn_s_setprio(0); } while (0)
#define PG8_WAIT_V(n) asm volatile("s_waitcnt vmcnt(" #n ")" ::: "memory")
#define PG8_WAIT_L(n) asm volatile("s_waitcnt lgkmcnt(" #n ")" ::: "memory")
#define PG8_BAR __builtin_amdgcn_s_barrier()
#define PG8_SCHED __builtin_amdgcn_sched_barrier(0)
    Unit cur, nxt; int ui = 0;
    if (!S.next(0, cur)) return;
    f32x4 acc[2][2][4][2];
#pragma unroll
    for (int a = 0; a < 2; ++a)
#pragma unroll
        for (int b = 0; b < 2; ++b)
#pragma unroll
            for (int m = 0; m < 4; ++m)
#pragma unroll
                for (int n = 0; n < 2; ++n) acc[a][b][m][n] = (f32x4){0.f, 0.f, 0.f, 0.f};
    bf16x8 At[4][2], B0[2][2], B1[2][2];
    const char* cA = (const char*)(cur.z ? g.A1 : g.A0) + (size_t)cur.pm * tstep; const char* cB = (const char*)(cur.z ? g.B1 : g.B0) + (size_t)cur.pn * tstep;
    PG8_STAGE(PG8_SB(0, 0), cB, voffB); PG8_STAGE(PG8_SB(0, 1), cB + hstep, voffB); PG8_STAGE(PG8_SA(0, 0), cA, voffA); PG8_STAGE(PG8_SA(0, 1), cA + hstep, voffA);
    if (wr == 1) PG8_BAR;
    PG8_WAIT_V(2); PG8_BAR;
    PG8_STAGE(PG8_SB(1, 0), cB + kstep, voffB); PG8_STAGE(PG8_SA(1, 0), cA + kstep, voffA); PG8_STAGE(PG8_SB(1, 1), cB + hstep + kstep, voffB);
    PG8_WAIT_V(6); PG8_BAR;
    for (;;) {
        const bool has_next = S.next(ui + 1, nxt);
        const char* nA = has_next ? (const char*)(nxt.z ? g.A1 : g.A0) + (size_t)nxt.pm * tstep : cA; const char* nB = has_next ? (const char*)(nxt.z ? g.B1 : g.B0) + (size_t)nxt.pn * tstep : cB;
        for (int t = 0; t < nt; t += 2) {
            const bool last = (t == nt - 2);
            const char* a1 = cA + (size_t)(t + 1) * kstep;
            const char* a2 = last ? nA : cA + (size_t)(t + 2) * kstep; const char* b2 = last ? nB : cB + (size_t)(t + 2) * kstep;
            const char* a3 = a2 + kstep; const char* b3 = b2 + kstep;
            PG8_LDB(B0, 0, 0); PG8_LDB(B1, 0, 1); PG8_SCHED; PG8_LDA(At, 0, 0); PG8_STAGE(PG8_SA(1, 1), a1 + hstep, voffA);
            PG8_WAIT_V(8); PG8_WAIT_L(0); PG8_BAR; PG8_MMA(0, 0, At, B0); PG8_MMA(0, 1, At, B1); PG8_BAR; PG8_SCHED;
            PG8_LDA(At, 0, 1); PG8_STAGE(PG8_SB(0, 0), b2, voffB); PG8_STAGE(PG8_SB(0, 1), b2 + hstep, voffB); PG8_STAGE(PG8_SA(0, 0), a2, voffA);
            PG8_WAIT_V(8); PG8_WAIT_L(0); PG8_BAR; PG8_MMA(1, 0, At, B0); PG8_MMA(1, 1, At, B1); PG8_BAR; PG8_SCHED;
            PG8_LDB(B0, 1, 0); PG8_LDB(B1, 1, 1); PG8_SCHED; PG8_LDA(At, 1, 0); PG8_STAGE(PG8_SA(0, 1), a2 + hstep, voffA);
            PG8_WAIT_V(8); PG8_WAIT_L(0); PG8_BAR; PG8_MMA(0, 0, At, B0); PG8_MMA(0, 1, At, B1); PG8_BAR; PG8_SCHED;
            PG8_LDA(At, 1, 1); PG8_STAGE(PG8_SB(1, 0), b3, voffB); PG8_STAGE(PG8_SB(1, 1), b3 + hstep, voffB); PG8_STAGE(PG8_SA(1, 0), a3, voffA);
            PG8_WAIT_V(8); PG8_WAIT_L(0); PG8_BAR; PG8_MMA(1, 0, At, B0); PG8_MMA(1, 1, At, B1); PG8_BAR; PG8_SCHED;
        }
        if (wr == 0) PG8_BAR;
        E(acc, cur.pm, cur.pn, cur.z, wr, wc, fr, fq);
        if (!has_next) break;
#pragma unroll
        for (int a = 0; a < 2; ++a)
#pragma unroll
            for (int b = 0; b < 2; ++b)
#pragma unroll
                for (int m = 0; m < 4; ++m)
#pragma unroll
                    for (int n = 0; n < 2; ++n) acc[a][b][m][n] = (f32x4){0.f, 0.f, 0.f, 0.f};
        cur = nxt; cA = nA; cB = nB; ++ui;
        if (wr == 1) PG8_BAR;
    }
    PG8_WAIT_V(0);
    PG8_BAR;
#undef PG8_SA
#undef PG8_SB
#undef PG8_STAGE
#undef PG8_LDA
#undef PG8_LDB
#undef PG8_MMA
#undef PG8_WAIT_V
#undef PG8_WAIT_L
#undef PG8_BAR
#undef PG8_SCHED
}
}

struct EpiIn {
    bf16_t *QF, *QS, *KF, *VF, *KS, *VS, *GF, *GS; const float* rope;
    __device__ __forceinline__ void operator()(const f32x4 (&acc)[2][2][4][2], int pm, int pn, int z, int wr, int wc, int fr, int fq) const {
#pragma unroll
        for (int bj = 0; bj < 2; ++bj) {
            bf16_t* base; int ld, col, mode;
            if (pn < 2) { base = QF; ld = 512; col = pn * 256 + bj * 128; mode = 1; }
            else if (pn < 4) { base = QS; ld = 512; col = (pn - 2) * 256 + bj * 128; mode = 2; }
            else if (pn < 6) { base = KF; ld = 512; col = (pn - 4) * 256 + bj * 128; mode = 0; }
            else if (pn < 8) { base = VF; ld = 512; col = (pn - 6) * 256 + bj * 128; mode = 0; }
            else if (pn == 8) { if (bj == 0) { base = KS; mode = 3; } else { base = VS; mode = 0; } ld = 128; col = 0; }
            else if (pn < 13) { base = GF; ld = 1024; col = (pn - 9) * 256 + bj * 128; mode = 4; }
            else { base = GS; ld = 1024; col = (pn - 13) * 256 + bj * 128; mode = 4; }
            char* tb = (char*)(base + (size_t)(pm * 256) * ld + col);
            const unsigned lo = (unsigned)((wr * 64 + fr) * ld + wc * 32 + 8 * fq) * 2u;
            const int j0 = 16 * (wc & 1) + 4 * fq;
            const int pos0 = ((pm * 256) & (SEQ - 1)) + wr * 64 + fr;
#pragma unroll
            for (int ai = 0; ai < 2; ++ai)
#pragma unroll
                for (int m = 0; m < 4; ++m) {
                    f32x4 v0 = acc[ai][bj][m][0], v1 = acc[ai][bj][m][1];
                    if (mode == 2 || mode == 3) {
                        const int pos = pos0 + ai * 128 + m * 16;
                        const f32x4 t0 = *(const f32x4*)(rope + (size_t)(pos * 32 + j0) * 2), t1 = *(const f32x4*)(rope + (size_t)(pos * 32 + j0 + 2) * 2);
                        f32x4 r0, r1;
                        r0[0] = v0[0] * t0[0] - v0[1] * t0[1]; r0[1] = v0[1] * t0[0] + v0[0] * t0[1];
                        r0[2] = v0[2] * t0[2] - v0[3] * t0[3]; r0[3] = v0[3] * t0[2] + v0[2] * t0[3];
                        r1[0] = v1[0] * t1[0] - v1[1] * t1[1]; r1[1] = v1[1] * t1[0] + v1[0] * t1[1];
                        r1[2] = v1[2] * t1[2] - v1[3] * t1[3]; r1[3] = v1[3] * t1[2] + v1[2] * t1[3];
                        v0 = r0; v1 = r1;
                    }
                    if (mode == 1 || mode == 2) { v0 = v0 * C2; v1 = v1 * C2; }
                    if (mode == 4) {
#pragma unroll
                        for (int i = 0; i < 4; ++i) { v0[i] = sigmoidf_(v0[i]); v1[i] = sigmoidf_(v1[i]); }
                    }
                    *(u32x4*)(tb + (size_t)((ai * 128 + m * 16) * ld * 2) + lo) = pk8(v0, v1);
                }
        }
    }
};
struct EpiGate {
    const bf16_t *GF, *GS; bf16_t* MG;
    __device__ __forceinline__ void operator()(const f32x4 (&acc)[2][2][4][2], int pm, int pn, int z, int wr, int wc, int fr, int fq) const {
        const size_t tile = (size_t)(pm * 256) * 1024 + pn * 256;
        const char* gb = (const char*)((z ? GS : GF) + tile); char* mb = (char*)(MG + tile);
        const unsigned lo = (unsigned)((wr * 64 + fr) * 1024 + wc * 32 + 8 * fq) * 2u;
#pragma unroll
        for (int ai = 0; ai < 2; ++ai)
#pragma unroll
            for (int m = 0; m < 4; ++m)
#pragma unroll
                for (int bj = 0; bj < 2; ++bj) {
                    const size_t d = (size_t)((ai * 128 + m * 16) * 1024 + bj * 128) * 2;
                    f32x4 g0, g1; unpk8(*(const u32x4*)(gb + d + lo), g0, g1);
                    f32x4 v0 = acc[ai][bj][m][0] * g0, v1 = acc[ai][bj][m][1] * g1;
                    if (z) { f32x4 p0, p1; unpk8(*(const u32x4*)(mb + d + lo), p0, p1); v0 += p0; v1 += p1; }
                    *(u32x4*)(mb + d + lo) = pk8(v0, v1);
                    if (bj) asm volatile("" ::: "memory");
                }
    }
};
struct EpiRes {
    const float* R; float* Y;
    __device__ __forceinline__ void operator()(const f32x4 (&acc)[2][2][4][2], int pm, int pn, int z, int wr, int wc, int fr, int fq) const {
        const size_t tile = (size_t)(pm * 256) * 1024 + pn * 256;
        const char* rb = (const char*)(R + tile); char* yb = (char*)(Y + tile);
        const unsigned lo = (unsigned)((wr * 64 + fr) * 1024 + wc * 32 + 8 * fq) * 4u;
#pragma unroll
        for (int ai = 0; ai < 2; ++ai)
#pragma unroll
            for (int m = 0; m < 4; ++m)
#pragma unroll
                for (int bj = 0; bj < 2; ++bj) {
                    const size_t d = (size_t)((ai * 128 + m * 16) * 1024 + bj * 128) * 4;
                    const f32x4 r0 = *(const f32x4*)(rb + d + lo), r1 = *(const f32x4*)(rb + d + lo + 16);
                    *(f32x4*)(yb + d + lo) = r0 * ALPHA + acc[ai][bj][m][0]; *(f32x4*)(yb + d + lo + 16) = r1 * ALPHA + acc[ai][bj][m][1];
                    if (bj) asm volatile("" ::: "memory");
                }
    }
};
struct EpiSwiglu {
    bf16_t* HM;
    __device__ __forceinline__ void operator()(const f32x4 (&acc)[2][2][4][2], int pm, int pn, int z, int wr, int wc, int fr, int fq) const {
        char* hb = (char*)(HM + (size_t)(pm * 256) * DFF + pn * 128);
        const unsigned lo = (unsigned)((wr * 64 + fr) * DFF + wc * 32 + 8 * fq) * 2u;
#pragma unroll
        for (int ai = 0; ai < 2; ++ai)
#pragma unroll
            for (int m = 0; m < 4; ++m) {
                f32x4 h0, h1;
#pragma unroll
                for (int i = 0; i < 4; ++i) { const float g0 = acc[ai][0][m][0][i], g1 = acc[ai][0][m][1][i];
                    h0[i] = g0 * sigmoidf_(g0) * acc[ai][1][m][0][i]; h1[i] = g1 * sigmoidf_(g1) * acc[ai][1][m][1][i]; }
                *(u32x4*)(hb + (size_t)((ai * 128 + m * 16) * DFF * 2) + lo) = pk8(h0, h1);
            }
    }
};

__device__ __forceinline__ void ln_rows(float* Y, const float* gam, const float* bet, bf16_t* HB) {
    int t_ = threadIdx.x; asm volatile("" : "+v"(t_));
    const int lane = t_ & 63, gw = blockIdx.x * NWAVES + __builtin_amdgcn_readfirstlane(t_ >> 6), ngw = gridDim.x * NWAVES;
    f32x4 gv[4], bv[4];
#pragma unroll
    for (int j = 0; j < 4; ++j) { gv[j] = *((const f32x4*)gam + lane + 64 * j); bv[j] = *((const f32x4*)bet + lane + 64 * j); }
    for (int m = gw; m < M; m += ngw) {
        f32x4* yr = (f32x4*)(Y + (size_t)m * DM) + lane;
        f32x4 v[4]; float s = 0.f;
#pragma unroll
        for (int j = 0; j < 4; ++j) { v[j] = yr[64 * j]; s += (v[j][0] + v[j][1]) + (v[j][2] + v[j][3]); }
        const float mean = wave_sum(s) * (1.f / DM); float s2 = 0.f;
#pragma unroll
        for (int j = 0; j < 4; ++j) { v[j] = v[j] - mean; s2 += (v[j][0] * v[j][0] + v[j][1] * v[j][1]) + (v[j][2] * v[j][2] + v[j][3] * v[j][3]); }
        const float rstd = 1.f / sqrtf(wave_sum(s2) * (1.f / DM) + LN_EPS);
#pragma unroll
        for (int j = 0; j < 4; ++j) {
            const f32x4 o = v[j] * rstd * gv[j] + bv[j];
            yr[64 * j] = o;
            if (HB) { u32x2 w; w.x = pk_bf16(o[0], o[1]); w.y = pk_bf16(o[2], o[3]); *((u32x2*)(HB + (size_t)m * DM) + lane + 64 * j) = w; }
        }
    }
}

template <int MODE> __device__ __forceinline__ void attn_simple(bf16_t* Q, const bf16_t* K, const bf16_t* V, const float* CL, const float* sinks, int gw, int ngw, int lane) {
    constexpr int KLD = MODE == 0 ? 512 : 128;
    for (int i = 0;; ++i) {
        const int u = gw + i * ngw; if (u >= 8192) break;
        const int bh = u >> 5; int qk = u & 31; if (i & 1) qk = 31 - qk;
        const int b = bh >> 3, h = bh & 7, kh = MODE == 0 ? h : (h >> 2);
        const int q = qk * 64 + lane;
        bf16_t* qp = Q + (size_t)(b * SEQ + q) * 512 + h * 64;
        float qv[64], o[64];
#pragma unroll
        for (int c = 0; c < 8; ++c) { const u32x4 w = *((const u32x4*)qp + c);
            qv[8 * c + 0] = bf_lo(w.x); qv[8 * c + 1] = bf_hi(w.x); qv[8 * c + 2] = bf_lo(w.y); qv[8 * c + 3] = bf_hi(w.y);
            qv[8 * c + 4] = bf_lo(w.z); qv[8 * c + 5] = bf_hi(w.z); qv[8 * c + 6] = bf_lo(w.w); qv[8 * c + 7] = bf_hi(w.w); }
#pragma unroll
        for (int d = 0; d < 64; ++d) o[d] = 0.f;
        float mx, l, cli = 0.f;
        if (MODE == 0) { mx = -INFINITY; l = 0.f; cli = CL[bh * SEQ + q]; } else { mx = sinks[h] * LOG2E; l = 1.f; }
        const int jlo = MODE == 0 ? 0 : (qk * 64 - 127 > 0 ? qk * 64 - 127 : 0), jhi = qk * 64 + 63;
        const bf16_t* kb = K + (size_t)(b * SEQ) * KLD + kh * 64;
        const bf16_t* vb = V + (size_t)(b * SEQ) * KLD + kh * 64;
        for (int j = jlo; j <= jhi; ++j) {
            const u32x4* kr = (const u32x4*)(kb + (size_t)j * KLD);
            float s = 0.f;
#pragma unroll
            for (int c = 0; c < 8; ++c) { const u32x4 w = kr[c];
                s += qv[8 * c + 0] * bf_lo(w.x) + qv[8 * c + 1] * bf_hi(w.x) + qv[8 * c + 2] * bf_lo(w.y) + qv[8 * c + 3] * bf_hi(w.y)
                   + qv[8 * c + 4] * bf_lo(w.z) + qv[8 * c + 5] * bf_hi(w.z) + qv[8 * c + 6] * bf_lo(w.w) + qv[8 * c + 7] * bf_hi(w.w); }
            bool act;
            if (MODE == 0) { s += cli - CL[bh * SEQ + j]; act = j <= q; } else { act = (j <= q) && (q - j < 128); }
            if (act) {
                const float mn = fmaxf(mx, s), sc = exp2f(mx - mn), p = exp2f(s - mn);
                mx = mn; l = l * sc + p;
                const u32x4* vr = (const u32x4*)(vb + (size_t)j * KLD);
#pragma unroll
                for (int c = 0; c < 8; ++c) { const u32x4 w = vr[c];
                    o[8 * c + 0] = o[8 * c + 0] * sc + p * bf_lo(w.x); o[8 * c + 1] = o[8 * c + 1] * sc + p * bf_hi(w.x);
                    o[8 * c + 2] = o[8 * c + 2] * sc + p * bf_lo(w.y); o[8 * c + 3] = o[8 * c + 3] * sc + p * bf_hi(w.y);
                    o[8 * c + 4] = o[8 * c + 4] * sc + p * bf_lo(w.z); o[8 * c + 5] = o[8 * c + 5] * sc + p * bf_hi(w.z);
                    o[8 * c + 6] = o[8 * c + 6] * sc + p * bf_lo(w.w); o[8 * c + 7] = o[8 * c + 7] * sc + p * bf_hi(w.w); }
            }
        }
        const float rl = 1.f / l;
#pragma unroll
        for (int c = 0; c < 8; ++c) { u32x4 w;
            w.x = pk_bf16(o[8 * c + 0] * rl, o[8 * c + 1] * rl); w.y = pk_bf16(o[8 * c + 2] * rl, o[8 * c + 3] * rl);
            w.z = pk_bf16(o[8 * c + 4] * rl, o[8 * c + 5] * rl); w.w = pk_bf16(o[8 * c + 6] * rl, o[8 * c + 7] * rl);
            *((u32x4*)qp + c) = w; }
    }
}

#include <hip/hip_bf16.h>
#include <cmath>
namespace attn_body {
using bf16=__hip_bfloat16;
using bf16x8=__attribute__((ext_vector_type(8)))short;
using s16x4=__attribute__((ext_vector_type(4)))short;
using f32x16=__attribute__((ext_vector_type(16)))float;
using u32x4=__attribute__((ext_vector_type(4)))unsigned;
constexpr int SEQ=2048,D=64;
constexpr int NW=8,QBLK=32,QB=QBLK*NW,KVBLK=64,NQB=SEQ/QB;
constexpr int ATTN_UNIT_ROWS=QB;
__device__ __forceinline__ int crow(int r,int hi){return (r&3)+8*(r>>2)+4*hi;}
#define SBAR() __builtin_amdgcn_sched_barrier(0)
__device__ __forceinline__ void cmask(f32x16&p0,f32x16&p1,int jb,int qrel,int hi){
  const float NEG=-INFINITY; int kb=64*jb+4*hi;
  #pragma unroll
  for(int r=0;r<16;++r){int kv=kb+(r&3)+8*(r>>2); if(kv>qrel)p0[r]=NEG; if(kv+32>qrel)p1[r]=NEG;}
}

__device__ __forceinline__ void nmask(f32x16&p0,f32x16&p1,int dq){
  const float NEG=-INFINITY;
  #pragma unroll
  for(int r=0;r<16;++r){int c=(r&3)+8*(r>>2); if(c>dq)p0[r]=NEG; if(c+32>dq)p1[r]=NEG;}
}
__device__ __forceinline__ void fmask(f32x16&p0,f32x16&p1,int dq){
  const float NEG=-INFINITY;
  #pragma unroll
  for(int r=0;r<16;++r){int c=(r&3)+8*(r>>2); if(c+128<=dq)p0[r]=NEG; if(c+160<=dq)p1[r]=NEG;}
}
typedef __attribute__((address_space(3))) const float* lds_fptr;
typedef float f32x4a __attribute__((ext_vector_type(4)));
constexpr int NSLOT=3, SLOTB=8192;
constexpr int LDS_K=0, LDS_V=NSLOT*SLOTB, LDS_WS=2*NSLOT*SLOTB, LDS_OST=LDS_WS+NW*64*4, LDS_BYTES=LDS_OST+NW*4096;
constexpr float C2=0.125f*1.4426950408889634f;
__device__ __forceinline__ void glds16(const void*gsrc,unsigned lds_dst){unsigned keep;
  asm volatile("s_mov_b32 %0, m0\n\ts_mov_b32 m0, %2\n\ts_nop 0\n\tglobal_load_lds_dwordx4 %1, off\n\ts_mov_b32 m0, %0":"=&s"(keep):"v"(gsrc),"s"(lds_dst):"memory");}
__device__ __forceinline__ float max3f(float a,float b,float c){float r;asm("v_max3_f32 %0, %1, %2, %3":"=v"(r):"v"(a),"v"(b),"v"(c));return r;}
__device__ __forceinline__ float max2f(float a,float b){float r;asm("v_max_f32_e32 %0, %1, %2":"=v"(r):"v"(a),"v"(b));return r;}
__device__ __forceinline__ float fadd_s(float a,float b){float r;asm("v_add_f32_e32 %0, %1, %2":"=v"(r):"v"(a),"v"(b));return r;}
__device__ __forceinline__ float fsub_s(float a,float b){float r;asm("v_sub_f32_e32 %0, %1, %2":"=v"(r):"v"(a),"v"(b));return r;}
typedef float f32x2_t __attribute__((ext_vector_type(2))); typedef __bf16 bf16x2_t __attribute__((ext_vector_type(2)));
__device__ __forceinline__ unsigned cvtpk_s(float lo,float hi){f32x2_t v={lo,hi};bf16x2_t b=__builtin_convertvector(v,bf16x2_t);return __builtin_bit_cast(unsigned,b);}
#define WAIT_BAR(N) asm volatile("s_waitcnt vmcnt(" #N ") lgkmcnt(0)\n\ts_barrier":::"memory")

__device__ __forceinline__ void qkt(f32x16&p0,f32x16&p1,const char*Kslot,const bf16x8*qr,const f32x16&negm,int r32,int hi){
  const char*kb=Kslot+hi*1024+r32*16;
  #pragma unroll
  for(int d0=0;d0<4;++d0){
    const bf16x8 b0=*reinterpret_cast<const bf16x8*>(kb+d0*2048);
    const bf16x8 b1=*reinterpret_cast<const bf16x8*>(kb+d0*2048+512);
    if(d0==0){p0=__builtin_amdgcn_mfma_f32_32x32x16_bf16(b0,qr[0],negm,0,0,0);p1=__builtin_amdgcn_mfma_f32_32x32x16_bf16(b1,qr[0],negm,0,0,0);}
    else{p0=__builtin_amdgcn_mfma_f32_32x32x16_bf16(b0,qr[d0],p0,0,0,0);p1=__builtin_amdgcn_mfma_f32_32x32x16_bf16(b1,qr[d0],p1,0,0,0);}}
}
typedef __attribute__((address_space(3))) const char* lds_cptr;
typedef short v4i16_t __attribute__((ext_vector_type(4)));
__device__ __forceinline__ void kload8(bf16x8*kf,lds_cptr kp){
  kf[0]=*(const __attribute__((address_space(3))) bf16x8*)(kp);      kf[1]=*(const __attribute__((address_space(3))) bf16x8*)(kp+512);
  kf[2]=*(const __attribute__((address_space(3))) bf16x8*)(kp+2048); kf[3]=*(const __attribute__((address_space(3))) bf16x8*)(kp+2560);
  kf[4]=*(const __attribute__((address_space(3))) bf16x8*)(kp+4096); kf[5]=*(const __attribute__((address_space(3))) bf16x8*)(kp+4608);
  kf[6]=*(const __attribute__((address_space(3))) bf16x8*)(kp+6144); kf[7]=*(const __attribute__((address_space(3))) bf16x8*)(kp+6656);
}
__device__ __forceinline__ void kload2(bf16x8*kf,lds_cptr kp,int j){ kf[2*j]=*(const __attribute__((address_space(3))) bf16x8*)(kp+j*2048); kf[2*j+1]=*(const __attribute__((address_space(3))) bf16x8*)(kp+j*2048+512); }
__device__ __forceinline__ s16x4 vtr(lds_cptr p){ return __builtin_bit_cast(s16x4,__builtin_amdgcn_ds_read_tr16_b64_v4i16((__attribute__((address_space(3))) v4i16_t*)p)); }
__device__ __forceinline__ float rowmax(const f32x16&p0,const f32x16&p1){
  float a=max3f(p0[0],p0[1],p1[0]),b=max3f(p0[2],p0[3],p1[1]);a=max3f(a,p1[2],p1[3]);
  #pragma unroll
  for(int r=4;r<16;r+=4){a=max3f(a,p0[r],p0[r+1]);b=max3f(b,p0[r+2],p0[r+3]);a=max3f(a,p1[r],p1[r+1]);b=max3f(b,p1[r+2],p1[r+3]);}
  const float m=max2f(a,b);
  auto rr=__builtin_amdgcn_permlane32_swap(__float_as_uint(m),__float_as_uint(m),false,false);
  return max2f(__uint_as_float(rr[0]),__uint_as_float(rr[1]));
}
__device__ __forceinline__ void pv(f32x16*o,int vb,bf16x8 pa0,bf16x8 pa1,bf16x8 pa2,bf16x8 pa3){
  #pragma unroll
  for(int d0=0;d0<2;++d0){s16x4 lo[4],hi[4];
    #pragma unroll
    for(int ks=0;ks<4;++ks){
      asm volatile("ds_read_b64_tr_b16 %0,%1 offset:%c2":"=&v"(lo[ks]):"v"(vb),"i"(d0*4096+ks*1024):"memory");
      asm volatile("ds_read_b64_tr_b16 %0,%1 offset:%c2":"=&v"(hi[ks]):"v"(vb),"i"(d0*4096+ks*1024+512):"memory");}
    asm volatile("s_waitcnt lgkmcnt(0)":::"memory");SBAR();
    #define PK(k) (bf16x8){lo[k][0],lo[k][1],lo[k][2],lo[k][3],hi[k][0],hi[k][1],hi[k][2],hi[k][3]}
    o[d0]=__builtin_amdgcn_mfma_f32_32x32x16_bf16(pa0,PK(0),o[d0],0,0,0);
    o[d0]=__builtin_amdgcn_mfma_f32_32x32x16_bf16(pa1,PK(1),o[d0],0,0,0);
    o[d0]=__builtin_amdgcn_mfma_f32_32x32x16_bf16(pa2,PK(2),o[d0],0,0,0);
    o[d0]=__builtin_amdgcn_mfma_f32_32x32x16_bf16(pa3,PK(3),o[d0],0,0,0);
    #undef PK
  }
}

#ifndef ATTN_STORE16
#define ATTN_STORE16(p,v) (*(u32x4*)(p)=(v))
#endif
template<int MODE,int THRL> __device__ __forceinline__ void attn_unit(int b,int h,int kh,int qb,const bf16*Q,const bf16*__restrict__ K,const bf16*__restrict__ V,bf16*O,char*shm,lds_fptr clrow,float sink2){
  constexpr int QP=512, KP=(MODE==0)?512:128;
  int tid=threadIdx.x; asm volatile("":"+v"(tid)); const int lane=tid&63,r32=lane&31,hi=lane>>5; const int wid=__builtin_amdgcn_readfirstlane(tid>>6);
  const long rowbase=(long)b*SEQ; const int q0=qb*QB;
  const int t0=(MODE==0)?0:(qb>0?4*qb-2:0);
  const int koff=64*(t0-4*qb);
  const bf16*Qw=Q+(rowbase+q0+wid*QBLK)*QP+h*D;
  const bf16*Kh=K+(rowbase+t0*KVBLK)*KP+kh*D,*Vh=V+(rowbase+t0*KVBLK)*KP+kh*D;
  const unsigned lds0=(unsigned)(uintptr_t)shm;
  float*wsf=(float*)(shm+LDS_WS)+wid*64;
  const bf16*ksrc=Kh+(long)lane*KP+wid*8;
  const bf16*vsrc=Vh+(long)(16*(wid&3)+(lane>>2))*KP+(wid>>2)*32+(lane&3)*8;
  const unsigned kdst=lds0+LDS_K+wid*1024, vdst=lds0+LDS_V+wid*1024;
  #define DMA_K(t,slot) glds16(ksrc+(long)(t)*KVBLK*KP,(unsigned)__builtin_amdgcn_readfirstlane(kdst+(slot)))
  #define DMA_V(t,slot) glds16(vsrc+(long)(t)*KVBLK*KP,(unsigned)__builtin_amdgcn_readfirstlane(vdst+(slot)))
  const int vb0=(int)(lds0+LDS_V)+((lane>>4)&1)*32+(lane&3)*8+(4*hi+((lane&15)>>2))*64;
  const char*Kbase=shm+LDS_K; bf16x8 kf[8];
  const lds_cptr shm3=(lds_cptr)shm; const lds_cptr kp0=shm3+LDS_K+hi*1024+r32*16; const lds_cptr vp0=shm3+LDS_V+((lane>>4)&1)*32+(lane&3)*8+(4*hi+((lane&15)>>2))*64;
  const int NT=(q0+QB)/KVBLK-t0;
  DMA_K(0,0);DMA_V(0,0);DMA_K(1,SLOTB);
  bf16x8 qr[4];
  #pragma unroll
  for(int d0=0;d0<4;++d0)qr[d0]=*reinterpret_cast<const bf16x8*>(&Qw[(long)r32*QP+d0*16+hi*8]);
  const int qrel=wid*QBLK+r32;
  float nb=0.f; if constexpr(MODE==0) nb=clrow[q0+qrel];
  float mhat=(MODE==0)?0.f:sink2,l_reg=(MODE==0)?0.f:(hi==0?1.f:0.f);f32x16 o[2];o[0]=f32x16{};o[1]=f32x16{};const f32x16 negm=f32x16{};
  const lds_fptr clk=clrow+4*hi;
  #define BIAS(P0,P1,t) do{ if constexpr(MODE==0){ const lds_fptr cp_=clk+(t)*64; const float sc_=mhat-nb; \
    _Pragma("unroll") for(int g_=0;g_<4;++g_){ f32x4a a_=*(const __attribute__((address_space(3))) f32x4a*)(cp_+8*g_), b_=*(const __attribute__((address_space(3))) f32x4a*)(cp_+32+8*g_); a_=a_+sc_; b_=b_+sc_; \
      P0[4*g_]-=a_[0];P0[4*g_+1]-=a_[1];P0[4*g_+2]-=a_[2];P0[4*g_+3]-=a_[3]; P1[4*g_]-=b_[0];P1[4*g_+1]-=b_[1];P1[4*g_+2]-=b_[2];P1[4*g_+3]-=b_[3]; } } \
    else { _Pragma("unroll") for(int r=0;r<16;++r){P0[r]-=mhat;P1[r]-=mhat;} } }while(0)
  #define CMASK(P0,P1,t) do{ if constexpr(MODE==0){int jb_=(t)-(NT-4); if(jb_>=0)cmask(P0,P1,jb_,qrel,hi);} else { const int kt_=koff+64*(t), qw_=32*wid; if(kt_+63>qw_)nmask(P0,P1,qrel-kt_-4*hi); else if(kt_<qw_-96)fmask(P0,P1,qrel-kt_-4*hi); } }while(0)
  bool resc=false;
  #define START(P0,P1) do{ const float rm=rowmax(P0,P1); resc=false; \
    { float dl=rm; if constexpr(MODE==1){ dl=__builtin_fmaxf(rm,0.f); l_reg*=__builtin_amdgcn_exp2f(-dl); } mhat=fadd_s(mhat,dl); \
      _Pragma("unroll") for(int r=0;r<16;++r){P0[r]=fsub_s(P0[r],dl);P1[r]=fsub_s(P1[r],dl);} \
      } \
    _Pragma("unroll") for(int r=0;r<16;++r)P0[r]=__builtin_amdgcn_exp2f(P0[r]); }while(0)
  #define RESC() do{ if(resc){ asm volatile("s_waitcnt lgkmcnt(0)":::"memory"); \
      _Pragma("unroll") for(int d_=0;d_<2;++d_) _Pragma("unroll") for(int r=0;r<16;++r)o[d_][r]*=wsf[crow(r,hi)]; } }while(0)
  f32x16 pA0,pA1,pB0,pB1;
  int sl_prev=0,sl_cur=0,sl_next=SLOTB;
  #define ROT() do{sl_prev=sl_cur;sl_cur=sl_next;sl_next=(sl_next==(NSLOT-1)*SLOTB)?0:sl_next+SLOTB;}while(0)
  DMA_K(2,2*SLOTB);
  WAIT_BAR(3);
  qkt(pA0,pA1,Kbase,qr,negm,r32,hi);asm volatile("s_nop 15\n\ts_nop 7":"+v"(pA0),"+v"(pA1));BIAS(pA0,pA1,0);CMASK(pA0,pA1,0);
  START(pA0,pA1);
  _Pragma("unroll") for(int r=0;r<16;++r)pA1[r]=__builtin_amdgcn_exp2f(pA1[r]);
  WAIT_BAR(0);
  DMA_K(3,0);DMA_V(1,SLOTB);
  ROT();
  kload8(kf,kp0+sl_cur);
  WAIT_BAR(2);
  s16x4 vlo[8],vhi[8]; u32x4 pw0,pw1,pw2,pw3;
  #define PKW(P,B) cvtpk_s(P[B],P[B+1])
  #define PAF(k) __builtin_bit_cast(bf16x8,pw##k)
  #define VFR(i) (bf16x8){vlo[i][0],vlo[i][1],vlo[i][2],vlo[i][3],vhi[i][0],vhi[i][1],vhi[i][2],vhi[i][3]}
  #define PIN(x) asm volatile("":"+v"(x))
  #define MX3(a,b,c) __builtin_fmaxf(__builtin_fmaxf((a),(b)),(c))
  #define GAPA(MF,A0,A1,A2,A3,W0,W1,PW) do{ MF; sacc+=A0; sacc+=A1; sacc+=A2; sacc+=A3; PIN(sacc); W0; W1; PIN(PW); SBAR(); }while(0)
  #define EX(v) __builtin_amdgcn_exp2f(v)
  #define GAPB(MF,X,B) do{ MF; X[B]=EX(X[B]); X[B+1]=EX(X[B+1]); X[B+2]=EX(X[B+2]); X[B+3]=EX(X[B+3]); PIN(X); SBAR(); }while(0)
  #define VRD(i) do{ vlo[i]=vtr(vp_+(((i)>>2)*4096+((i)&3)*1024)); vhi[i]=vtr(vp_+(((i)>>2)*4096+((i)&3)*1024+512)); }while(0)
  #define KRD(G,j) do{ if(G){ kload2(kf,kp0+sl_next,j); SBAR(); } }while(0)
  #define STEP(C0,C1,P0,P1,t,GK,GV,GL) do{ SBAR(); \
    const lds_cptr vp_=vp0+sl_prev; \
    VRD(0); SBAR(); float sacc=(P0[0]+P0[1]); \
    GAPA(C0=__builtin_amdgcn_mfma_f32_32x32x16_bf16(kf[0],qr[0],negm,0,0,0), P0[2],P0[3],P0[4],P0[5],     pw0[0]=PKW(P0,0), pw0[1]=PKW(P0,2), pw0); \
    VRD(4); SBAR(); GAPA(C1=__builtin_amdgcn_mfma_f32_32x32x16_bf16(kf[1],qr[0],negm,0,0,0), P0[6],P0[7],P0[8],P0[9],     pw0[2]=PKW(P0,4), pw0[3]=PKW(P0,6), pw0); \
    VRD(1); SBAR(); GAPA(C0=__builtin_amdgcn_mfma_f32_32x32x16_bf16(kf[2],qr[1],C0,0,0,0),   P0[10],P0[11],P0[12],P0[13], pw1[0]=PKW(P0,8), pw1[1]=PKW(P0,10), pw1); \
    VRD(5); SBAR(); GAPA(C1=__builtin_amdgcn_mfma_f32_32x32x16_bf16(kf[3],qr[1],C1,0,0,0),   P0[14],P0[15],P1[0],P1[1],   pw1[2]=PKW(P0,12),pw1[3]=PKW(P0,14), pw1); \
    VRD(2); SBAR(); GAPA(C0=__builtin_amdgcn_mfma_f32_32x32x16_bf16(kf[4],qr[2],C0,0,0,0),   P1[2],P1[3],P1[4],P1[5],     pw2[0]=PKW(P1,0), pw2[1]=PKW(P1,2), pw2); \
    VRD(6); SBAR(); GAPA(C1=__builtin_amdgcn_mfma_f32_32x32x16_bf16(kf[5],qr[2],C1,0,0,0),   P1[6],P1[7],P1[8],P1[9],     pw2[2]=PKW(P1,4), pw2[3]=PKW(P1,6), pw2); \
    VRD(3); SBAR(); GAPA(C0=__builtin_amdgcn_mfma_f32_32x32x16_bf16(kf[6],qr[3],C0,0,0,0),   P1[10],P1[11],P1[12],P1[13], pw3[0]=PKW(P1,8), pw3[1]=PKW(P1,10), pw3); \
    VRD(7); SBAR(); GAPA(C1=__builtin_amdgcn_mfma_f32_32x32x16_bf16(kf[7],qr[3],C1,0,0,0),   P1[14],P1[15],0.f,0.f,       pw3[2]=PKW(P1,12),pw3[3]=PKW(P1,14), pw3); \
    l_reg+=sacc; \
    if(GK){DMA_K((t)+3,sl_cur);} if(GV){DMA_V((t)+1,sl_next);} \
    BIAS(C0,C1,t); CMASK(C0,C1,t); \
    { float a=MX3(C0[0],C0[1],C1[0]),b=MX3(C0[2],C0[3],C1[1]); a=MX3(a,C1[2],C1[3]); \
      _Pragma("unroll") for(int r=4;r<16;r+=4){a=MX3(a,C0[r],C0[r+1]);b=MX3(b,C0[r+2],C0[r+3]);a=MX3(a,C1[r],C1[r+1]);b=MX3(b,C1[r+2],C1[r+3]);} \
      float rm=__builtin_fmaxf(a,b); { auto rr=__builtin_amdgcn_permlane32_swap(__float_as_uint(rm),__float_as_uint(rm),false,false); rm=__builtin_fmaxf(__uint_as_float(rr[0]),__uint_as_float(rr[1])); } \
      resc=false; \
      if(__builtin_expect(__any(rm>(float)THRL),0)){ const float dl=__builtin_fmaxf(rm,0.f); mhat+=dl; \
        _Pragma("unroll") for(int r=0;r<16;++r){C0[r]-=dl;C1[r]-=dl;} \
        const float f=__builtin_amdgcn_exp2f(-dl); l_reg*=f; if(hi==0)wsf[r32]=f; resc=true; } } \
    SBAR(); \
    GAPB(o[0]=__builtin_amdgcn_mfma_f32_32x32x16_bf16(PAF(0),VFR(0),o[0],0,0,0), C0,0); \
    GAPB(o[1]=__builtin_amdgcn_mfma_f32_32x32x16_bf16(PAF(0),VFR(4),o[1],0,0,0), C0,4); \
    KRD(GL,0); GAPB(o[0]=__builtin_amdgcn_mfma_f32_32x32x16_bf16(PAF(1),VFR(1),o[0],0,0,0), C0,8); \
    KRD(GL,1); GAPB(o[1]=__builtin_amdgcn_mfma_f32_32x32x16_bf16(PAF(1),VFR(5),o[1],0,0,0), C0,12); \
    KRD(GL,2); GAPB(o[0]=__builtin_amdgcn_mfma_f32_32x32x16_bf16(PAF(2),VFR(2),o[0],0,0,0), C1,0); \
    KRD(GL,3); GAPB(o[1]=__builtin_amdgcn_mfma_f32_32x32x16_bf16(PAF(2),VFR(6),o[1],0,0,0), C1,4); \
    GAPB(o[0]=__builtin_amdgcn_mfma_f32_32x32x16_bf16(PAF(3),VFR(3),o[0],0,0,0), C1,8); \
    GAPB(o[1]=__builtin_amdgcn_mfma_f32_32x32x16_bf16(PAF(3),VFR(7),o[1],0,0,0), C1,12); \
    }while(0)
  int t=1;
  #undef CMASK
  #define CMASK(P0,P1,t) do{}while(0)
  for(;t+5<NT;t+=2){
    STEP(pB0,pB1,pA0,pA1,t,true,true,true);     WAIT_BAR(2); RESC(); ROT();
    STEP(pA0,pA1,pB0,pB1,t+1,true,true,true);   WAIT_BAR(2); RESC(); ROT();
  }
  #undef CMASK
  #define CMASK(P0,P1,t) do{ if constexpr(MODE==0){int jb_=(t)-(NT-4); if(jb_>=0)cmask(P0,P1,jb_,qrel,hi);} else { const int kt_=koff+64*(t), qw_=32*wid; if(kt_+63>qw_)nmask(P0,P1,qrel-kt_-4*hi); else if(kt_<qw_-96)fmask(P0,P1,qrel-kt_-4*hi); } }while(0)
  #define ENDW(tt) do{ if((tt)+3<NT){WAIT_BAR(2);} else if((tt)+2<NT){WAIT_BAR(1);} else {WAIT_BAR(0);} }while(0)
  for(;t+1<NT;t+=2){
    STEP(pB0,pB1,pA0,pA1,t,(t+3<NT),(t+1<NT),(t+1<NT));       ENDW(t);   RESC(); ROT();
    STEP(pA0,pA1,pB0,pB1,t+1,(t+4<NT),(t+2<NT),(t+2<NT));     ENDW(t+1); RESC(); ROT();
  }
  STEP(pB0,pB1,pA0,pA1,NT-1,false,false,false); RESC();
  { float sacc=pB0[0]+pB0[1]; _Pragma("unroll") for(int r=2;r<16;++r)sacc+=pB0[r]; _Pragma("unroll") for(int r=0;r<16;++r)sacc+=pB1[r]; l_reg+=sacc;
    pw0=(u32x4){PKW(pB0,0),PKW(pB0,2),PKW(pB0,4),PKW(pB0,6)};pw1=(u32x4){PKW(pB0,8),PKW(pB0,10),PKW(pB0,12),PKW(pB0,14)};pw2=(u32x4){PKW(pB1,0),PKW(pB1,2),PKW(pB1,4),PKW(pB1,6)};pw3=(u32x4){PKW(pB1,8),PKW(pB1,10),PKW(pB1,12),PKW(pB1,14)};
    SBAR(); pv(o,vb0+sl_cur,PAF(0),PAF(1),PAF(2),PAF(3)); }
  #undef PKW
  #undef PAF
  #undef VFR
  #undef PIN
  #undef MX3
  #undef GAPA
  #undef GAPB
  #undef EX
  #undef VRD
  #undef KRD
  #undef STEP
  #undef ENDW
  {auto rr=__builtin_amdgcn_permlane32_swap(__float_as_uint(l_reg),__float_as_uint(l_reg),false,false);l_reg=__uint_as_float(rr[0])+__uint_as_float(rr[1]);}
  if(hi==0)wsf[32+r32]=l_reg;asm volatile("s_waitcnt lgkmcnt(0)":::"memory");
  float rli[16];
  #pragma unroll
  for(int r=0;r<16;++r)rli[r]=__builtin_amdgcn_rcpf(wsf[32+crow(r,hi)]);
  bf16*Ow=O+(rowbase+q0+wid*QBLK)*QP+h*D;
  { bf16*stg=(bf16*)(shm+LDS_OST)+wid*2048;
    #pragma unroll
    for(int r=0;r<16;++r){const int orow=crow(r,hi);
      #pragma unroll
      for(int d0=0;d0<2;++d0)stg[orow*64+d0*32+r32]=__float2bfloat16(o[d0][r]*rli[r]);}
    asm volatile("s_waitcnt lgkmcnt(0)":::"memory");
    #pragma unroll
    for(int i=0;i<4;++i){const int row=i*8+(lane>>3),ch=lane&7; const u32x4 v=*(const u32x4*)(stg+row*64+ch*8); ATTN_STORE16(Ow+(long)row*QP+ch*8,v);} }
  asm volatile("s_waitcnt lgkmcnt(0)\n\ts_barrier":::"memory");
  #undef DMA_K
  #undef DMA_V
  #undef BIAS
  #undef CMASK
  #undef START
  #undef RESC
  #undef ROT
}
constexpr int ATTN_LDS_BYTES=LDS_BYTES;
#undef SBAR
#undef WAIT_BAR
}

constexpr int ATT_CL_OFF = 98304;
__device__ __forceinline__ void attn_fast(unsigned char* lds, const float* CL, const float* sinks, bf16_t* QF, const bf16_t* KF, const bf16_t* VF, bf16_t* QS, const bf16_t* KS, const bf16_t* VS) {
    using namespace attn_body;
    static_assert(ATTN_LDS_BYTES <= ATT_CL_OFF && ATT_CL_OFF + 8192 <= ::LDS_BYTES, "attention LDS map");
    int tid = threadIdx.x; asm volatile("" : "+v"(tid));
    float* cl_l = (float*)(lds + ATT_CL_OFF);
#ifndef NO_M0
    for (int bh = blockIdx.x; bh < BATCH * 8; bh += gridDim.x) {
        __syncthreads();
        *(f32x4*)(cl_l + tid * 4) = *(const f32x4*)(CL + (size_t)bh * 2048 + tid * 4);
        __syncthreads();
        for (int qb = 7; qb >= 0; --qb)
            attn_unit<0, 8>(bh >> 3, bh & 7, bh & 7, qb, (const bf16*)QF, (const bf16*)KF, (const bf16*)VF, (bf16*)QF, (char*)lds, (lds_fptr)cl_l, 0.f);
    }
#endif
#ifndef NO_M1
    for (int bh = blockIdx.x; bh < BATCH * 8; bh += gridDim.x) {
        const float s2 = sinks[bh & 7] * LOG2E;
        for (int qb = 7; qb >= 0; --qb)
            attn_unit<1, 8>(bh >> 3, bh & 7, (bh & 7) >> 2, qb, (const bf16*)QS, (const bf16*)KS, (const bf16*)VS, (bf16*)QS, (char*)lds, (lds_fptr)nullptr, s2);
    }
#endif
}

struct Params { const float* in[14]; float* out; unsigned char* ws; };

__global__ void __launch_bounds__(NTHREADS, 2) fwd_kernel(Params p) {
    extern __shared__ __attribute__((aligned(16))) unsigned char lds[];
    cg::grid_group grid = cg::this_grid();
    const int tid = threadIdx.x, lane = tid & 63, wid = __builtin_amdgcn_readfirstlane(tid >> 6);
    const int gw = blockIdx.x * NWAVES + wid, ngw = gridDim.x * NWAVES;
    const int gtid = blockIdx.x * NTHREADS + tid, ngt = gridDim.x * NTHREADS;
    unsigned char* ws = p.ws;
#ifdef SIMPLE_GEMM
#define RUN_GEMM(g, E) gemm_simple(g, E)
#else
#define RUN_GEMM(g, E) do { pg8::Order S_; S_.init((g).nM, (g).nN, (g).nZ, (int)gridDim.x, (int)blockIdx.x); pg8::gemm_phase((PG8_LAS unsigned char*)lds, g, S_, E); } while (0)
#endif
    const float *x = p.in[0], *w_in = p.in[1], *b_forget = p.in[2], *sinks = p.in[3], *w_o_fox = p.in[4], *w_o_swa = p.in[5], *w_out = p.in[6],
                *ln1_g = p.in[7], *ln1_b = p.in[8], *w_gate = p.in[9], *w_up = p.in[10], *w_down = p.in[11], *ln2_g = p.in[12], *ln2_b = p.in[13];
    float* rope = (float*)(ws + WS_ROPE); float* logf_ = (float*)(ws + WS_LOGF); float* CL = (float*)(ws + WS_CL);
    bf16_t *WIN = (bf16_t*)(ws + WS_WIN), *WOF = (bf16_t*)(ws + WS_WOF), *WOS = (bf16_t*)(ws + WS_WOS), *WOUT = (bf16_t*)(ws + WS_WOUT), *WGU = (bf16_t*)(ws + WS_WGU), *WD = (bf16_t*)(ws + WS_WD);
    bf16_t *XB = (bf16_t*)(ws + WS_XB), *QF = (bf16_t*)(ws + WS_QF), *QS = (bf16_t*)(ws + WS_QS), *KF = (bf16_t*)(ws + WS_KF), *VF = (bf16_t*)(ws + WS_VF),
           *KS = (bf16_t*)(ws + WS_KS), *VS = (bf16_t*)(ws + WS_VS), *GF = (bf16_t*)(ws + WS_GF), *GS = (bf16_t*)(ws + WS_GS), *HM = (bf16_t*)(ws + WS_HM);

    conv_w(DM, NPROJ, INCOLS, WIN, ColIn{w_in}, gtid, ngt);
    conv_w(512, DM, DM, WOF, ColId{w_o_fox}, gtid, ngt);
    conv_w(512, DM, DM, WOS, ColId{w_o_swa}, gtid, ngt);
    conv_w(DM, DM, DM, WOUT, ColId{w_out}, gtid, ngt);
    conv_w(DM, NGU, DFF, WGU, ColGU{w_gate, w_up}, gtid, ngt);
    conv_w(DFF, DM, DM, WD, ColId{w_down}, gtid, ngt);
    for (int it = gtid; it < SEQ * 32; it += ngt) {
        const int pos = it >> 5, j = it & 31;
        const float inv_freq = exp2f(-(float)j * (13.287712379549449f / 32.f));
        const float ang = (float)pos * inv_freq;
        float c, s; sincos_acc(ang, c, s);
        rope[2 * it] = c; rope[2 * it + 1] = s;
    }
#ifndef NO_P0
    {
        f32x4 wf[4][4][2];
#pragma unroll
        for (int j = 0; j < 4; ++j)
#pragma unroll
            for (int e = 0; e < 4; ++e) { const float* wp = w_in + (size_t)(256 * j + 4 * lane + e) * INCOLS + 1536; wf[j][e][0] = *(const f32x4*)wp; wf[j][e][1] = *(const f32x4*)(wp + 4); }
        const float bfv = b_forget[lane & 7];
        for (int m = gw; m < M; m += ngw) {
            const f32x4* xr = (const f32x4*)(x + (size_t)m * DM) + lane;
            f32x4 a0 = {0.f, 0.f, 0.f, 0.f}, a1 = {0.f, 0.f, 0.f, 0.f};
#pragma unroll
            for (int j = 0; j < 4; ++j) { const f32x4 v = xr[64 * j];
                u32x2 w; w.x = pk_bf16(v[0], v[1]); w.y = pk_bf16(v[2], v[3]); *((u32x2*)(XB + (size_t)m * DM) + lane + 64 * j) = w;
#pragma unroll
                for (int e = 0; e < 4; ++e) { a0 += wf[j][e][0] * v[e]; a1 += wf[j][e][1] * v[e]; } }
            float r[8] = {a0[0], a0[1], a0[2], a0[3], a1[0], a1[1], a1[2], a1[3]};
#pragma unroll
            for (int hh = 0; hh < 8; ++hh) r[hh] = wave_sum(r[hh]);
            float mine = r[0];
#pragma unroll
            for (int hh = 1; hh < 8; ++hh) mine = (lane & 7) == hh ? r[hh] : mine;
            if (lane < 8) { const float zz = mine + bfv; logf_[(size_t)m * 8 + lane] = fminf(zz, 0.f) - log1pf(__expf(-fabsf(zz))); }
        }
    }
#endif
    grid.sync();

    {
        double* sc = (double*)lds;
        for (int seq = blockIdx.x; seq < BATCH * 8; seq += gridDim.x) {
            const int b = seq >> 3, h = seq & 7;
            double v[4]; double s = 0.0;
#pragma unroll
            for (int e = 0; e < 4; ++e) { v[e] = (double)logf_[(size_t)(b * SEQ + tid * 4 + e) * 8 + h]; s += v[e]; }
            __syncthreads();
            sc[tid] = s;
            __syncthreads();
            double pre = 0.0;
            for (int i = 0; i < tid; ++i) pre += sc[i];
#pragma unroll
            for (int e = 0; e < 4; ++e) { pre += v[e]; CL[(size_t)seq * SEQ + tid * 4 + e] = (float)(pre * 1.4426950408889634); }
        }
        __syncthreads();
        Gemm g{XB, XB, WIN, WIN, DM, DM, DM, M / 256, NPROJ / 256, 1};
#ifndef NO_P1
        RUN_GEMM(g, (EpiIn{QF, QS, KF, VF, KS, VS, GF, GS, rope}));
#endif
    }
    grid.sync();

#ifdef SIMPLE_ATTN
    attn_simple<0>(QF, KF, VF, CL, sinks, gw, ngw, lane);
    attn_simple<1>(QS, KS, VS, CL, sinks, gw, ngw, lane);
#else
    attn_fast(lds, CL, sinks, QF, KF, VF, QS, KS, VS);
#endif
    grid.sync();

    { Gemm g{QF, QS, WOF, WOS, 512, 512, 512, M / 256, DM / 256, 2}; RUN_GEMM(g, (EpiGate{GF, GS, XB})); }
    grid.sync();

    { Gemm g{XB, XB, WOUT, WOUT, DM, DM, DM, M / 256, DM / 256, 1}; RUN_GEMM(g, (EpiRes{x, p.out})); }
    grid.sync();
    ln_rows(p.out, ln1_g, ln1_b, XB);
    grid.sync();

    { Gemm g{XB, XB, WGU, WGU, DM, DM, DM, M / 256, NGU / 256, 1}; RUN_GEMM(g, (EpiSwiglu{HM})); }
    grid.sync();

    { Gemm g{HM, HM, WD, WD, DFF, DFF, DFF, M / 256, DM / 256, 1}; RUN_GEMM(g, (EpiRes{p.out, p.out})); }
    grid.sync();
    ln_rows(p.out, ln2_g, ln2_b, nullptr);
}

extern "C" void kernel_launch(void* const* d_in, const int* in_sizes, int n_in, void* d_out, int out_size, void* d_ws, size_t ws_size, hipStream_t stream) {
    static int grid_blocks = 0;
    if (grid_blocks == 0) {
        if (n_in != 14 || out_size != M * DM || ws_size < WS_END) { fprintf(stderr, "kernel_launch: unexpected shapes (n_in %d out %d ws %zu)\n", n_in, out_size, ws_size); grid_blocks = -1; return; }
        int dev = 0, cus = 0, per_cu = 0;
        hipGetDevice(&dev);
        hipDeviceGetAttribute(&cus, hipDeviceAttributeMultiprocessorCount, dev);
        hipFuncSetAttribute((const void*)fwd_kernel, hipFuncAttributeMaxDynamicSharedMemorySize, LDS_BYTES);
        hipOccupancyMaxActiveBlocksPerMultiprocessor(&per_cu, (const void*)fwd_kernel, NTHREADS, LDS_BYTES);
        if (per_cu < 1) { fprintf(stderr, "kernel_launch: occupancy query says %d blocks per CU\n", per_cu); per_cu = 1; }
        (void)hipGetLastError();
        grid_blocks = cus * 1;
    }
    if (grid_blocks < 0) return;
    Params p{};
    for (int i = 0; i < 14; ++i) p.in[i] = (const float*)d_in[i];
    p.out = (float*)d_out; p.ws = (unsigned char*)d_ws;
    void* args[] = {&p};
    hipError_t e = hipLaunchCooperativeKernel((const void*)fwd_kernel, dim3(grid_blocks), dim3(NTHREADS), args, LDS_BYTES, stream);
    if (e != hipSuccess) fprintf(stderr, "cooperative launch failed: %s (grid %d)\n", hipGetErrorString(e), grid_blocks);
}
```
